# Optimizing an MI355X kernel written in HIP

```python
import math
import jax, jax.numpy as jnp
from jax import lax
import numpy as np

D_MODEL = 2048
BATCH = 16
SEQ = 2048
DEPTH = 1

HEAD_DIM = 128
D_MIX = D_MODEL
GLA_HEADS = D_MIX // 2 // HEAD_DIM
GLA_DK = HEAD_DIM // 2
GLA_DV = HEAD_DIM
GLA_RANK = 16
GLA_TAU = 16.0
GLA_CHUNK = 64
FOX_HEADS = D_MIX // 4 // HEAD_DIM
FOX_BLOCK = 128
MEM_HEADS = 4
MEM_TOKENS = 256
N_OUT_HEADS = GLA_HEADS + FOX_HEADS + MEM_HEADS
D_FF = 4 * D_MODEL
EPS = 1e-6

kernel_name = "hymba_gla_fox_memory_layer"


def _in_widths():
    return (
        GLA_HEADS * GLA_DK,
        GLA_HEADS * GLA_DK,
        GLA_HEADS * GLA_DV,
        GLA_HEADS * GLA_DV,
        GLA_RANK,
        FOX_HEADS * HEAD_DIM,
        FOX_HEADS * HEAD_DIM,
        FOX_HEADS * HEAD_DIM,
        FOX_HEADS * HEAD_DIM,
        FOX_HEADS,
        MEM_HEADS * HEAD_DIM,
        MEM_HEADS * HEAD_DIM,
    )


def _split_points():
    pts, acc = [], 0
    for w in _in_widths()[:-1]:
        acc += w
        pts.append(acc)
    return pts


def rms_norm(x, g):
    xf = x.astype(jnp.float32)
    y = xf * lax.rsqrt(jnp.mean(xf * xf, axis=-1, keepdims=True) + EPS)
    return (y * g.astype(jnp.float32)).astype(x.dtype)


def _heads(t, h):
    return t.reshape(t.shape[0], t.shape[1], h, -1).transpose(0, 2, 1, 3)


def gla_chunked(q, k, v, log_a):
    B, H, S, DK = q.shape
    DV = v.shape[-1]
    C = GLA_CHUNK
    n = S // C

    def to_chunks(t):
        return t.reshape(B, H, n, C, t.shape[-1]).transpose(2, 0, 1, 3, 4)

    qc = to_chunks(q * (DK ** -0.5))
    kc, vc, gc = to_chunks(k), to_chunks(v), to_chunks(log_a)
    causal = jnp.tril(jnp.ones((C, C), dtype=bool))[:, :, None]

    def step(state, xs):
        qi, ki, vi, gi = xs
        b = jnp.cumsum(gi.astype(jnp.float32), axis=2)
        inter = jnp.einsum('bhck,bhkv->bhcv', qi * jnp.exp(b), state)
        rel = b[:, :, :, None, :] - b[:, :, None, :, :]
        decay = jnp.exp(jnp.where(causal, rel, -jnp.inf))
        scores = jnp.einsum('bhik,bhijk,bhjk->bhij', qi.astype(jnp.float32), decay,
                            ki.astype(jnp.float32))
        intra = jnp.einsum('bhij,bhjv->bhiv', scores, vi.astype(jnp.float32))
        b_last = b[:, :, -1:, :]
        new_state = (jnp.exp(b_last[:, :, 0, :])[..., None] * state
                     + jnp.einsum('bhck,bhcv->bhkv', ki * jnp.exp(b_last - b),
                                  vi.astype(jnp.float32)))
        return new_state, inter + intra

    state0 = jnp.zeros((B, H, DK, DV), jnp.float32)
    _, out = lax.scan(step, state0, (qc, kc, vc, gc))
    return out.transpose(1, 2, 0, 3, 4).reshape(B, H, S, DV)


def forgetting_attention(q, k, v, log_f):
    B, H, S, D = q.shape
    scale = D ** -0.5
    c = jnp.cumsum(log_f.astype(jnp.float32), axis=-1)
    outs = []
    for i in range(S // FOX_BLOCK):
        q0, q1 = i * FOX_BLOCK, (i + 1) * FOX_BLOCK
        qb, kb, vb = q[:, :, q0:q1], k[:, :, :q1], v[:, :, :q1]
        logits = (jnp.einsum('bhqd,bhkd->bhqk', qb, kb).astype(jnp.float32) * scale
                  + c[:, :, q0:q1, None] - c[:, :, None, :q1])
        mask = (q0 + jnp.arange(FOX_BLOCK))[:, None] >= jnp.arange(q1)[None, :]
        p = jax.nn.softmax(jnp.where(mask, logits, -jnp.inf), axis=-1)
        outs.append(jnp.einsum('bhqk,bhkd->bhqd', p.astype(v.dtype), vb))
    return jnp.concatenate(outs, axis=2)


def setup_inputs(seed: int = 0) -> dict:
    key = jax.random.key(seed)
    ks = jax.random.split(key, 20)
    n = jax.random.normal
    d_in = sum(_in_widths())
    return {
        "x": n(ks[0], (BATCH, SEQ, D_MODEL), jnp.float32),
        "mem": n(ks[1], (BATCH, MEM_TOKENS, D_MODEL), jnp.float32),
        "attn_norm_g": 1.0 + 0.02 * n(ks[2], (D_MODEL,), jnp.float32),
        "w_in": n(ks[3], (D_MODEL, d_in), jnp.float32) * D_MODEL ** -0.5,
        "gla_a_w2": n(ks[4], (GLA_RANK, GLA_HEADS * GLA_DK), jnp.float32) * GLA_RANK ** -0.5,
        "gla_a_b": 0.5 * n(ks[5], (GLA_HEADS * GLA_DK,), jnp.float32),
        "fox_f_b": 3.0 + 0.5 * n(ks[6], (FOX_HEADS,), jnp.float32),
        "fox_q_norm_g": 1.0 + 0.02 * n(ks[7], (HEAD_DIM,), jnp.float32),
        "fox_k_norm_g": 1.0 + 0.02 * n(ks[8], (HEAD_DIM,), jnp.float32),
        "mem_norm_g": 1.0 + 0.02 * n(ks[9], (D_MODEL,), jnp.float32),
        "w_mem_kv": n(ks[10], (D_MODEL, 2 * MEM_HEADS * HEAD_DIM), jnp.float32) * D_MODEL ** -0.5,
        "mem_q_norm_g": 1.0 + 0.02 * n(ks[11], (HEAD_DIM,), jnp.float32),
        "mem_k_norm_g": 1.0 + 0.02 * n(ks[12], (HEAD_DIM,), jnp.float32),
        "out_norm_g": 1.0 + 0.02 * n(ks[13], (N_OUT_HEADS * HEAD_DIM,), jnp.float32),
        "w_out": n(ks[14], (N_OUT_HEADS * HEAD_DIM, D_MODEL), jnp.float32) * (N_OUT_HEADS * HEAD_DIM) ** -0.5,
        "mlp_norm_g": 1.0 + 0.02 * n(ks[15], (D_MODEL,), jnp.float32),
        "w_up": n(ks[16], (D_MODEL, D_FF), jnp.float32) * D_MODEL ** -0.5,
        "w_down": n(ks[17], (D_FF, D_MODEL), jnp.float32) * D_FF ** -0.5,
    }


def reference(x, mem, attn_norm_g, w_in, gla_a_w2, gla_a_b, fox_f_b, fox_q_norm_g,
              fox_k_norm_g, mem_norm_g, w_mem_kv, mem_q_norm_g, mem_k_norm_g,
              out_norm_g, w_out, mlp_norm_g, w_up, w_down):
    B, S, _ = x.shape
    h = x
    for _layer in range(DEPTH):
        xn = rms_norm(h, attn_norm_g)
        proj = xn @ w_in
        (gq, gk, gv, gg, ga, fq, fk, fv, fg, ff, mq, mg) = jnp.split(proj, _split_points(), axis=-1)

        log_a = jax.nn.log_sigmoid((ga @ gla_a_w2 + gla_a_b).astype(jnp.float32)) / GLA_TAU
        gla_o = gla_chunked(_heads(gq, GLA_HEADS), _heads(gk, GLA_HEADS),
                            _heads(gv, GLA_HEADS), _heads(log_a, GLA_HEADS))
        gla_o = gla_o.astype(x.dtype).transpose(0, 2, 1, 3)

        fq_h = rms_norm(_heads(fq, FOX_HEADS), fox_q_norm_g)
        fk_h = rms_norm(_heads(fk, FOX_HEADS), fox_k_norm_g)
        log_f = jax.nn.log_sigmoid((ff + fox_f_b).astype(jnp.float32)).transpose(0, 2, 1)
        fox_o = forgetting_attention(fq_h, fk_h, _heads(fv, FOX_HEADS), log_f)
        fox_o = fox_o.astype(x.dtype).transpose(0, 2, 1, 3)

        mn = rms_norm(mem, mem_norm_g)
        mk, mv = jnp.split(mn @ w_mem_kv, 2, axis=-1)
        mk = rms_norm(mk.reshape(B, mem.shape[1], MEM_HEADS, HEAD_DIM), mem_k_norm_g)
        mv = mv.reshape(B, mem.shape[1], MEM_HEADS, HEAD_DIM)
        mq_h = rms_norm(mq.reshape(B, S, MEM_HEADS, HEAD_DIM), mem_q_norm_g)
        m_logits = jnp.einsum('bshd,bmhd->bhsm', mq_h, mk).astype(jnp.float32) * HEAD_DIM ** -0.5
        m_p = jax.nn.softmax(m_logits, axis=-1)
        mem_o = jnp.einsum('bhsm,bmhd->bshd', m_p.astype(mv.dtype), mv)

        o = jnp.concatenate([gla_o, fox_o, mem_o], axis=2)
        o = rms_norm(o, out_norm_g.reshape(N_OUT_HEADS, HEAD_DIM)).reshape(B, S, -1)
        gate = jnp.concatenate([jax.nn.silu(gg), jax.nn.sigmoid(fg), jax.nn.sigmoid(mg)], axis=-1)
        h = h + (o * gate) @ w_out

        u = jax.nn.relu(rms_norm(h, mlp_norm_g) @ w_up)
        h = h + (u * u) @ w_down
    return h
```

```cpp
#include <hip/hip_runtime.h>
#include <hip/hip_cooperative_groups.h>
#include <cstdio>
#include <cstdint>
namespace cg = cooperative_groups;

#define LAS __attribute__((address_space(3)))
#define GAS __attribute__((address_space(1)))
typedef unsigned short bf16_t;
typedef short bf16x8 __attribute__((ext_vector_type(8)));
typedef short s16x4 __attribute__((ext_vector_type(4)));
typedef float f32x4 __attribute__((ext_vector_type(4)));
typedef float f32x16 __attribute__((ext_vector_type(16)));
typedef unsigned u32x4 __attribute__((ext_vector_type(4)));
typedef unsigned u32x2 __attribute__((ext_vector_type(2)));

constexpr int NB = 16, SEQ = 2048, DM = 2048, T = NB * SEQ, DFF = 8192, MEMT = 256, TM = NB * MEMT;
constexpr int NIN = 6164, NINP = 6400, LDP = 6144;
constexpr int C_GQ = 0, C_GK = 512, C_GV = 1024, C_GG = 2048, C_FQ = 3072, C_FK = 3584, C_FV = 4096, C_FG = 4608, C_MQ = 5120, C_MG = 5632;
constexpr float EPS = 1e-6f;
constexpr float LOG2E = 1.4426950408889634f;

constexpr size_t MiB = 1u << 20;
constexpr size_t WS_ROWSQ = 0;
constexpr size_t WS_NEGC = 1 * MiB;
constexpr size_t WS_GATES = 2 * MiB;
constexpr size_t WS_CTL = 7 * MiB, CTL_BYTES = 32768;
constexpr size_t WS_WIN = 8 * MiB;
constexpr size_t WS_WOUT = 34 * MiB;
constexpr size_t WS_WUP = 42 * MiB;
constexpr size_t WS_WDN = 74 * MiB;
constexpr size_t WS_WMKV = 106 * MiB;
constexpr size_t WS_MN = 110 * MiB;
constexpr size_t WS_MKV = 126 * MiB;
constexpr size_t WS_XN = 134 * MiB;
constexpr size_t WS_HB = 262 * MiB;
constexpr size_t WS_BIG = 390 * MiB;
constexpr size_t WS_END = 902 * MiB;

namespace pg8 {
constexpr int BM = 256, BK = 64, HALF = 128, HTB = HALF * BK * 2, STAGE_BYTES = 8 * HTB, NXCD = 8, WGM = 8;
__host__ __device__ __forceinline__ int lds_byte(int r, int c) { const int st = (r >> 4) * 2 + (c >> 5), rr = r & 15, cc = c & 31, ob = rr * 64 + cc * 2; return st * 1024 + (ob ^ (((ob >> 9) & 1) << 5)); }
__host__ __device__ __forceinline__ void stage_rc(int b, int& R, int& C) { const int st = b / 1024, sb = b % 1024, swz = sb ^ (((sb >> 9) & 1) << 5); R = (st >> 1) * 16 + swz / 64; C = (st & 1) * 32 + (swz % 64) / 2; }
__host__ __device__ __forceinline__ int perm32(int rho) { const int n = rho >> 4, i = rho & 15; return 8 * (i >> 2) + 4 * n + (i & 3); }

struct Unit { int pm, pn, g; };

__device__ __forceinline__ void tile_of(int wgid, int nM, int nN, int& pm, int& pn) {
    const int nwg = nM * nN;
    { const int q = nwg / NXCD, r = nwg % NXCD, xcd = wgid % NXCD, off = wgid / NXCD; wgid = (xcd < r ? xcd * (q + 1) : r * (q + 1) + (xcd - r) * q) + off; }
    const int nig = WGM * nN, gid = wgid / nig, fm = gid * WGM, gsz = (nM - fm) < WGM ? (nM - fm) : WGM;
    pm = fm + ((wgid % nig) % gsz); pn = (wgid % nig) / gsz;
}
struct OrderOne {
    const bf16_t* A; const bf16_t* Bt; int nM, nN, nwg, G, c;
    __device__ __forceinline__ bool next(int i, Unit& u) const { const long L = (long)i * G + c; if (L >= nwg) return false; tile_of((int)L, nM, nN, u.pm, u.pn); u.g = 0; return true; }
    __device__ __forceinline__ const char* abase(const Unit& u, size_t tstep) const { return (const char*)A + (size_t)u.pm * tstep; }
    __device__ __forceinline__ const char* bbase(const Unit& u, size_t tstep) const { return (const char*)Bt + (size_t)u.pn * tstep; }
};
struct OrderTwo {
    const bf16_t* A0; const bf16_t* B0; const bf16_t* A1; const bf16_t* B1; int nM0, nN0, nM1, nN1, G, c;
    __device__ __forceinline__ bool next(int i, Unit& u) const {
        long L = (long)i * G + c; const int n0 = nM0 * nN0;
        if (L < n0) { tile_of((int)L, nM0, nN0, u.pm, u.pn); u.g = 0; return true; }
        L -= n0; if (L >= nM1 * nN1) return false;
        u.pm = (int)L / nN1; u.pn = (int)L % nN1; u.g = 1; return true;
    }
    __device__ __forceinline__ const char* abase(const Unit& u, size_t tstep) const { return (const char*)(u.g ? A1 : A0) + (size_t)u.pm * tstep; }
    __device__ __forceinline__ const char* bbase(const Unit& u, size_t tstep) const { return (const char*)(u.g ? B1 : B0) + (size_t)u.pn * tstep; }
};

__device__ __forceinline__ unsigned cvt_pk_bf16(float lo, float hi) { unsigned r; asm volatile("v_cvt_pk_bf16_f32 %0, %1, %2" : "=v"(r) : "v"(lo), "v"(hi)); return r; }

template <class Epi, class Sched, bool ALIGN_EPI = true, bool SP2 = true>
__device__ __forceinline__ void gemm_phase(LAS unsigned char* lds, const int K, const Sched& S, const Epi& E) {
    const int tid = threadIdx.x, wid = __builtin_amdgcn_readfirstlane(tid >> 6), lane = tid & 63, wr = wid >> 2, wc = wid & 3, fr = lane & 15, fq = lane >> 4;
    const int nt = K / BK;
    unsigned voffA[2], voffB[2];
#pragma unroll
    for (int i = 0; i < 2; ++i) { int R, C; stage_rc(tid * 16 + i * 8192, R, C); const int Rb = Epi::PERM ? ((R & ~31) + perm32(R & 31)) : R;
        voffA[i] = (unsigned)(R * K + C) * 2u; voffB[i] = (unsigned)(Rb * K + C) * 2u; }
    const size_t kstep = (size_t)(BK * 2);
    const size_t hstep = (size_t)HALF * K * 2;
    const size_t tstep = 2 * hstep;
    const unsigned ldsw = (unsigned)wid * 1024u;
    const int aoff = lds_byte(wr * 64 + fr, fq * 8), boff = lds_byte(wc * 32 + fr, fq * 8);
#define PG8_SA(b, h) (((b) * 2 + (h)) * HTB)
#define PG8_SB(b, h) ((4 + (b) * 2 + (h)) * HTB)
#define PG8_STAGE(bufoff, gbase, voff) do { _Pragma("unroll") for (int _i = 0; _i < 2; ++_i) \
        __builtin_amdgcn_global_load_lds((const unsigned*)((const char*)(gbase) + (voff)[_i]), (LAS unsigned*)(lds + (bufoff) + ldsw + _i * 8192), 16, 0, 0); } while (0)
#define PG8_LDA(dst, b, h) do { _Pragma("unroll") for (int m = 0; m < 4; ++m) _Pragma("unroll") for (int k = 0; k < 2; ++k) dst[m][k] = *(const LAS bf16x8*)(lds + PG8_SA(b, h) + aoff + m * 2048 + k * 1024); } while (0)
#define PG8_LDB(dst, b, h) do { _Pragma("unroll") for (int n = 0; n < 2; ++n) _Pragma("unroll") for (int k = 0; k < 2; ++k) dst[n][k] = *(const LAS bf16x8*)(lds + PG8_SB(b, h) + boff + n * 2048 + k * 1024); } while (0)
#define PG8_MMA(ai, bj, At, Bt) do { __builtin_amdgcn_s_setprio(1); _Pragma("unroll") for (int m = 0; m < 4; ++m) _Pragma("unroll") for (int n = 0; n < 2; ++n) _Pragma("unroll") for (int k = 0; k < 2; ++k) \
        acc[ai][bj][m][n] = __builtin_amdgcn_mfma_f32_16x16x32_bf16(Bt[n][k], At[m][k], acc[ai][bj][m][n], 0, 0, 0); __builtin_amdgcn_s_setprio(0); } while (0)
#define PG8_WAIT_V(n) asm volatile("s_waitcnt vmcnt(" #n ")" ::: "memory")
#define PG8_WAIT_L(n) asm volatile("s_waitcnt lgkmcnt(" #n ")" ::: "memory")
#define PG8_BAR __builtin_amdgcn_s_barrier()
#define PG8_SCHED __builtin_amdgcn_sched_barrier(0)
    Unit cur, nxt; int ui = 0;
    if (!S.next(0, cur)) return;
    f32x4 acc[2][2][4][2];
#pragma unroll
    for (int a = 0; a < 2; ++a)
#pragma unroll
        for (int b = 0; b < 2; ++b)
#pragma unroll
            for (int m = 0; m < 4; ++m)
#pragma unroll
                for (int n = 0; n < 2; ++n) acc[a][b][m][n] = (f32x4){0.f, 0.f, 0.f, 0.f};
    bf16x8 At[4][2], B0[2][2], B1[2][2];
    const char* cA = S.abase(cur, tstep); const char* cB = S.bbase(cur, tstep);
    if constexpr (SP2) {
        PG8_STAGE(PG8_SB(0, 0), cB, voffB); PG8_STAGE(PG8_SB(0, 1), cB + hstep, voffB); PG8_STAGE(PG8_SA(0, 0), cA, voffA); PG8_STAGE(PG8_SA(0, 1), cA + hstep, voffA);
        if (wr == 1) PG8_BAR;
        PG8_WAIT_V(2); PG8_BAR;
        PG8_STAGE(PG8_SB(1, 0), cB + kstep, voffB); PG8_STAGE(PG8_SA(1, 0), cA + kstep, voffA); PG8_STAGE(PG8_SB(1, 1), cB + hstep + kstep, voffB);
        PG8_WAIT_V(6); PG8_BAR;
    } else {
        PG8_STAGE(PG8_SB(0, 0), cB, voffB); PG8_STAGE(PG8_SA(0, 0), cA, voffA); PG8_STAGE(PG8_SB(0, 1), cB + hstep, voffB); PG8_STAGE(PG8_SA(0, 1), cA + hstep, voffA);
        if (wr == 1) PG8_BAR;
        PG8_WAIT_V(4); PG8_BAR;
        PG8_STAGE(PG8_SB(1, 0), cB + kstep, voffB); PG8_STAGE(PG8_SA(1, 0), cA + kstep, voffA); PG8_STAGE(PG8_SB(1, 1), cB + hstep + kstep, voffB);
        PG8_WAIT_V(6); PG8_BAR;
    }
    for (;;) {
        const bool has_next = S.next(ui + 1, nxt);
        const char* nA = has_next ? S.abase(nxt, tstep) : cA; const char* nB = has_next ? S.bbase(nxt, tstep) : cB;
        for (int t = 0; t < nt; t += 2) {
            const bool last = (t == nt - 2);
            const char* a1 = cA + (size_t)(t + 1) * kstep;
            const char* a2 = last ? nA : cA + (size_t)(t + 2) * kstep; const char* b2 = last ? nB : cB + (size_t)(t + 2) * kstep;
            const char* a3 = a2 + kstep; const char* b3 = b2 + kstep;
            if constexpr (SP2) {
            PG8_LDB(B0, 0, 0); PG8_LDB(B1, 0, 1); PG8_SCHED; PG8_LDA(At, 0, 0); PG8_STAGE(PG8_SA(1, 1), a1 + hstep, voffA);
            PG8_WAIT_V(8); PG8_WAIT_L(0); PG8_BAR; PG8_MMA(0, 0, At, B0); PG8_MMA(0, 1, At, B1); PG8_BAR; PG8_SCHED;
            PG8_LDA(At, 0, 1); PG8_STAGE(PG8_SB(0, 0), b2, voffB); PG8_STAGE(PG8_SB(0, 1), b2 + hstep, voffB); PG8_STAGE(PG8_SA(0, 0), a2, voffA);
            PG8_WAIT_V(8); PG8_WAIT_L(0); PG8_BAR; PG8_MMA(1, 0, At, B0); PG8_MMA(1, 1, At, B1); PG8_BAR; PG8_SCHED;
            PG8_LDB(B0, 1, 0); PG8_LDB(B1, 1, 1); PG8_SCHED; PG8_LDA(At, 1, 0); PG8_STAGE(PG8_SA(0, 1), a2 + hstep, voffA);
            PG8_WAIT_V(8); PG8_WAIT_L(0); PG8_BAR; PG8_MMA(0, 0, At, B0); PG8_MMA(0, 1, At, B1); PG8_BAR; PG8_SCHED;
            PG8_LDA(At, 1, 1); PG8_STAGE(PG8_SB(1, 0), b3, voffB); PG8_STAGE(PG8_SB(1, 1), b3 + hstep, voffB); PG8_STAGE(PG8_SA(1, 0), a3, voffA);
            PG8_WAIT_V(8); PG8_WAIT_L(0); PG8_BAR; PG8_MMA(1, 0, At, B0); PG8_MMA(1, 1, At, B1); PG8_BAR; PG8_SCHED;
            } else {
            PG8_LDB(B0, 0, 0); PG8_SCHED; PG8_LDA(At, 0, 0); PG8_STAGE(PG8_SA(1, 1), a1 + hstep, voffA);
            PG8_WAIT_L(8); PG8_BAR; PG8_WAIT_L(0); PG8_MMA(0, 0, At, B0); PG8_BAR; PG8_SCHED;
            PG8_LDB(B1, 0, 1); PG8_STAGE(PG8_SB(0, 0), b2, voffB);
            PG8_BAR; PG8_WAIT_L(0); PG8_MMA(0, 1, At, B1); PG8_BAR;
            PG8_LDA(At, 0, 1); PG8_STAGE(PG8_SA(0, 0), a2, voffA);
            PG8_BAR; PG8_WAIT_L(0); PG8_MMA(1, 0, At, B0); PG8_BAR; PG8_SCHED;
            PG8_STAGE(PG8_SB(0, 1), b2 + hstep, voffB);
            PG8_WAIT_V(6); PG8_BAR; PG8_MMA(1, 1, At, B1); PG8_BAR;
            PG8_LDB(B0, 1, 0); PG8_SCHED; PG8_LDA(At, 1, 0); PG8_STAGE(PG8_SA(0, 1), a2 + hstep, voffA);
            PG8_WAIT_L(8); PG8_BAR; PG8_WAIT_L(0); PG8_MMA(0, 0, At, B0); PG8_BAR; PG8_SCHED;
            PG8_LDB(B1, 1, 1); PG8_STAGE(PG8_SB(1, 0), b3, voffB);
            PG8_BAR; PG8_WAIT_L(0); PG8_MMA(0, 1, At, B1); PG8_BAR;
            PG8_LDA(At, 1, 1); PG8_STAGE(PG8_SA(1, 0), a3, voffA);
            PG8_BAR; PG8_WAIT_L(0); PG8_MMA(1, 0, At, B0); PG8_BAR; PG8_SCHED;
            PG8_STAGE(PG8_SB(1, 1), b3 + hstep, voffB);
            PG8_WAIT_V(6); PG8_BAR; PG8_MMA(1, 1, At, B1); PG8_BAR;
            }
        }
        if constexpr (ALIGN_EPI) { if (wr == 0) PG8_BAR; }
        E(acc, cur, wr, wc, fr, fq);
        if (!has_next) break;
#pragma unroll
        for (int a = 0; a < 2; ++a)
#pragma unroll
            for (int b = 0; b < 2; ++b)
#pragma unroll
                for (int m = 0; m < 4; ++m)
#pragma unroll
                    for (int n = 0; n < 2; ++n) acc[a][b][m][n] = (f32x4){0.f, 0.f, 0.f, 0.f};
        cur = nxt; cA = nA; cB = nB; ++ui;
        if constexpr (ALIGN_EPI) { if (wr == 1) PG8_BAR; }
    }
    PG8_WAIT_V(0);
    if constexpr (!ALIGN_EPI) { if (wr == 0) PG8_BAR; }
    PG8_BAR;
#undef PG8_SA
#undef PG8_SB
#undef PG8_STAGE
#undef PG8_LDA
#undef PG8_LDB
#undef PG8_MMA
#undef PG8_WAIT_V
#undef PG8_WAIT_L
#undef PG8_BAR
#undef PG8_SCHED
}

__device__ __forceinline__ u32x4 pack8(f32x4 a, f32x4 b) { u32x4 w; w.x = cvt_pk_bf16(a[0], a[1]); w.y = cvt_pk_bf16(a[2], a[3]); w.z = cvt_pk_bf16(b[0], b[1]); w.w = cvt_pk_bf16(b[2], b[3]); return w; }

struct EpiP1 {
    static constexpr bool PERM = true;
    bf16_t* proj; float* gates; bf16_t* mkv;
    __device__ __forceinline__ void operator()(const f32x4 (&acc)[2][2][4][2], const Unit& u, int wr, int wc, int fr, int fq) const {
        const int row0 = u.pm * BM + wr * 64 + fr;
        if (u.g == 0 && u.pn == 24) {
            if (wc == 0) {
#pragma unroll
                for (int ai = 0; ai < 2; ++ai)
#pragma unroll
                    for (int m = 0; m < 4; ++m) { float* p = gates + (size_t)(row0 + ai * HALF + m * 16) * 32 + 8 * fq; *(f32x4*)p = acc[ai][0][m][0]; *(f32x4*)(p + 4) = acc[ai][0][m][1]; }
            }
            return;
        }
        bf16_t* base = u.g ? mkv : proj; const int ldc = u.g ? 1024 : LDP;
        const int col0 = u.pn * BM + wc * 32 + 8 * fq;
#pragma unroll
        for (int ai = 0; ai < 2; ++ai)
#pragma unroll
            for (int m = 0; m < 4; ++m) { bf16_t* rowp = base + (size_t)(row0 + ai * HALF + m * 16) * ldc + col0;
#pragma unroll
                for (int bj = 0; bj < 2; ++bj) *(u32x4*)(rowp + bj * HALF) = pack8(acc[ai][bj][m][0], acc[ai][bj][m][1]); }
    }
};
struct EpiP4 {
    static constexpr bool PERM = true;
    const float* x; float* out; bf16_t* hb; float* rowsq;
    __device__ __forceinline__ void operator()(const f32x4 (&acc)[2][2][4][2], const Unit& u, int wr, int wc, int fr, int fq) const {
        const int row0 = u.pm * BM + wr * 64 + fr; const int col0 = u.pn * BM + wc * 32 + 8 * fq;
#pragma unroll
        for (int ai = 0; ai < 2; ++ai)
#pragma unroll
            for (int m = 0; m < 4; ++m) { const int row = row0 + ai * HALF + m * 16; const size_t off = (size_t)row * DM + col0; float ss = 0.f;
#pragma unroll
                for (int bj = 0; bj < 2; ++bj) {
                    const f32x4 h0 = *(const f32x4*)(x + off + bj * HALF) + acc[ai][bj][m][0], h1 = *(const f32x4*)(x + off + bj * HALF + 4) + acc[ai][bj][m][1];
                    *(u32x4*)(hb + off + bj * HALF) = pack8(h0, h1);
                    ss += (h0[0] * h0[0] + h0[1] * h0[1]) + (h0[2] * h0[2] + h0[3] * h0[3]) + (h1[0] * h1[0] + h1[1] * h1[1]) + (h1[2] * h1[2] + h1[3] * h1[3]);
                }
                ss += __shfl_xor(ss, 16); ss += __shfl_xor(ss, 32);
                if (fq == 0) atomicAdd(rowsq + row, ss);
            }
    }
};
struct EpiP5 {
    static constexpr bool PERM = true;
    const float* rowsq; bf16_t* ub;
    __device__ __forceinline__ void operator()(const f32x4 (&acc)[2][2][4][2], const Unit& u, int wr, int wc, int fr, int fq) const {
        const int row0 = u.pm * BM + wr * 64 + fr; const int col0 = u.pn * BM + wc * 32 + 8 * fq;
#pragma unroll
        for (int ai = 0; ai < 2; ++ai)
#pragma unroll
            for (int m = 0; m < 4; ++m) { const int row = row0 + ai * HALF + m * 16; const float r = __builtin_amdgcn_rsqf(rowsq[row] * (1.0f / DM) + EPS);
                bf16_t* rowp = ub + (size_t)row * DFF + col0;
                const float r2 = r * r;
#pragma unroll
                for (int bj = 0; bj < 2; ++bj) { f32x4 a = acc[ai][bj][m][0], b = acc[ai][bj][m][1];
#pragma unroll
                    for (int e = 0; e < 4; ++e) { a[e] = fmaxf(a[e], 0.f); b[e] = fmaxf(b[e], 0.f); }
                    a = (a * a) * r2; b = (b * b) * r2;
                    *(u32x4*)(rowp + bj * HALF) = pack8(a, b); } }
    }
};
struct EpiP6 {
    static constexpr bool PERM = true;
    const bf16_t* hb; float* out;
    __device__ __forceinline__ void operator()(const f32x4 (&acc)[2][2][4][2], const Unit& u, int wr, int wc, int fr, int fq) const {
        const int row0 = u.pm * BM + wr * 64 + fr; const int col0 = u.pn * BM + wc * 32 + 8 * fq;
#pragma unroll
        for (int ai = 0; ai < 2; ++ai)
#pragma unroll
            for (int m = 0; m < 4; ++m) { const size_t off = (size_t)(row0 + ai * HALF + m * 16) * DM + col0;
#pragma unroll
                for (int bj = 0; bj < 2; ++bj) { const u32x4 hv = *(const u32x4*)(hb + off + bj * HALF);
                    f32x4 h0, h1;
                    h0[0] = __uint_as_float(hv.x << 16); h0[1] = __uint_as_float(hv.x & 0xffff0000u); h0[2] = __uint_as_float(hv.y << 16); h0[3] = __uint_as_float(hv.y & 0xffff0000u);
                    h1[0] = __uint_as_float(hv.z << 16); h1[1] = __uint_as_float(hv.z & 0xffff0000u); h1[2] = __uint_as_float(hv.w << 16); h1[3] = __uint_as_float(hv.w & 0xffff0000u);
                    *(f32x4*)(out + off + bj * HALF) = h0 + acc[ai][bj][m][0]; *(f32x4*)(out + off + bj * HALF + 4) = h1 + acc[ai][bj][m][1]; } }
    }
};
}

namespace att {
constexpr int D = 128, NW = 8, QBLK = 32, KVBLK = 64, QB = NW * QBLK;
constexpr int SHM_V = KVBLK * D * 2, SHM_K = KVBLK * D * 2;
constexpr int LDS_WS = 2 * SHM_V + 2 * SHM_K;
constexpr int LDS_NEGC = LDS_WS + NW * 64 * 4;
constexpr int LDS_STG = LDS_NEGC + 2048 * 4;
constexpr int SP = 132;
constexpr int LDS_BYTES = LDS_STG + NW * 16 * SP * 4;
constexpr float SCALE = 0.08838834764831845f;
constexpr float THR = 8.f;
#define KSWZ(row, colB) ((row) * 256 + ((colB) ^ (((row) & 7) << 4)))
#define SBAR() __builtin_amdgcn_sched_barrier(0)
__device__ __forceinline__ int v_st(int k, int c) { const int kk = (k & ~0xC) | ((k & 4) << 1) | ((k & 8) >> 1); return ((kk >> 3) * 4 + (c >> 5)) * 512 + ((kk & 7) * 32 + (c & 31)) * 2; }
__device__ __forceinline__ int v_rd_base(int lane) { return ((lane & 3) << 3) | (((lane >> 2) & 3) << 6) | (((lane >> 4) & 1) << 5) | (((lane >> 5) & 1) << 8); }
constexpr int v_rd_off(int d0, int ks, int half) { return d0 * 512 + ks * 4096 + half * 2048; }
__device__ __forceinline__ int crow(int r, int hi) { return (r & 3) + 8 * (r >> 2) + 4 * hi; }
__device__ __forceinline__ unsigned cvtpk(float lo, float hi) { unsigned r; asm volatile("v_cvt_pk_bf16_f32 %0, %1, %2" : "=v"(r) : "v"(lo), "v"(hi)); return r; }
__device__ __forceinline__ bf16x8 ld8(const bf16_t* p) { return *reinterpret_cast<const bf16x8*>(p); }
__device__ __forceinline__ float bf2f(unsigned short b) { return __uint_as_float((unsigned)b << 16); }

__device__ __forceinline__ void mask_tile(f32x16& p0, f32x16& p1, int dq) {
    const float NEG = -__builtin_inff();
#pragma unroll
    for (int r = 0; r < 16; ++r) {
        const int c = (r & 3) + 8 * (r >> 2);
        if (dq - c < 0) p0[r] = NEG;
        if (dq - c - 32 < 0) p1[r] = NEG;
    }
}
__device__ __forceinline__ void partialSM(f32x16& p0, f32x16& p1, float& m_reg, float& mn, float& alpha) {
    float pmax = p0[0];
#pragma unroll
    for (int r = 1; r < 16; ++r) pmax = fmaxf(pmax, p0[r]);
#pragma unroll
    for (int r = 0; r < 16; ++r) pmax = fmaxf(pmax, p1[r]);
    { auto rr = __builtin_amdgcn_permlane32_swap(__float_as_uint(pmax), __float_as_uint(pmax), false, false);
      pmax = fmaxf(__uint_as_float(rr[0]), __uint_as_float(rr[1])); }
    constexpr float C2 = 1.4426950408889634f * SCALE;
    if (__builtin_expect(__all((pmax - m_reg) * SCALE <= THR), 1)) { mn = m_reg; alpha = 1.f; }
    else { mn = fmaxf(m_reg, pmax); alpha = __builtin_amdgcn_exp2f((m_reg - mn) * C2); m_reg = mn; }
    const float mnL = -mn * C2;
#pragma unroll
    for (int r = 0; r < 16; ++r) p0[r] = fmaf(p0[r], C2, mnL);
#pragma unroll
    for (int r = 0; r < 16; ++r) p1[r] = fmaf(p1[r], C2, mnL);
#pragma unroll
    for (int r = 0; r < 16; ++r) p0[r] = __builtin_amdgcn_exp2f(p0[r]);
}
__device__ __forceinline__ void finishSM(f32x16& p0, f32x16& p1, float alpha, float& l_reg, bf16x8& pa0, bf16x8& pa1, bf16x8& pa2, bf16x8& pa3) {
#pragma unroll
    for (int r = 0; r < 16; ++r) p1[r] = __builtin_amdgcn_exp2f(p1[r]);
    float ps = 0;
#pragma unroll
    for (int r = 0; r < 16; ++r) ps += p0[r];
#pragma unroll
    for (int r = 0; r < 16; ++r) ps += p1[r];
    { auto rr = __builtin_amdgcn_permlane32_swap(__float_as_uint(ps), __float_as_uint(ps), false, false);
      ps = __uint_as_float(rr[0]) + __uint_as_float(rr[1]); }
    l_reg = l_reg * alpha + ps;
#define PK4(P, B_, OUT) do { unsigned a0 = cvtpk(P[B_+0], P[B_+1]), a1 = cvtpk(P[B_+2], P[B_+3]);                          \
        unsigned b0 = cvtpk(P[B_+4], P[B_+5]), b1 = cvtpk(P[B_+6], P[B_+7]);                                             \
        auto r0 = __builtin_amdgcn_permlane32_swap(a0, b0, false, false); auto r1 = __builtin_amdgcn_permlane32_swap(a1, b1, false, false); \
        u32x4 w = {r0[0], r1[0], r0[1], r1[1]}; OUT = *reinterpret_cast<bf16x8*>(&w); } while (0)
    PK4(p0, 0, pa0); PK4(p0, 8, pa1); PK4(p1, 0, pa2); PK4(p1, 8, pa3);
#undef PK4
}
template <int KB, bool BIAS>
__device__ __forceinline__ void qkt(f32x16& p0, f32x16& p1, const char* K_lds, int r32, int hi, const bf16x8* qr, const LAS float* nb) {
    if (BIAS) {
#pragma unroll
        for (int g = 0; g < 4; ++g) { const f32x4 a = *(const LAS f32x4*)(nb + 8 * g), b = *(const LAS f32x4*)(nb + 8 * g + 32);
            p0[4 * g] = a[0]; p0[4 * g + 1] = a[1]; p0[4 * g + 2] = a[2]; p0[4 * g + 3] = a[3];
            p1[4 * g] = b[0]; p1[4 * g + 1] = b[1]; p1[4 * g + 2] = b[2]; p1[4 * g + 3] = b[3]; }
    } else { p0 = f32x16{}; p1 = f32x16{}; }
    const char* kb[4];
#pragma unroll
    for (int dd = 0; dd < 4; ++dd) kb[dd] = K_lds + KB * SHM_K + KSWZ(r32, (dd * 16 + hi * 8) * 2);
#pragma unroll
    for (int d0 = 0; d0 < 8; ++d0) { const char* a = kb[d0 & 3] + (d0 >> 2) * 128;
        bf16x8 b0 = *reinterpret_cast<const bf16x8*>(a);
        bf16x8 b1 = *reinterpret_cast<const bf16x8*>(a + 32 * 256);
        p0 = __builtin_amdgcn_mfma_f32_32x32x16_bf16(b0, qr[d0], p0, 0, 0, 0);
        p1 = __builtin_amdgcn_mfma_f32_32x32x16_bf16(b1, qr[d0], p1, 0, 0, 0); }
}
template <int VB>
__device__ __forceinline__ void pv_tile(f32x16* o, int vb0, bf16x8 pa0, bf16x8 pa1, bf16x8 pa2, bf16x8 pa3) {
#define TRRD(dst, off) asm volatile("ds_read_b64_tr_b16 %0, %1 offset:%2" : "=&v"(dst) : "v"(vb0), "i"(off) : "memory")
#define PV_D0(d0) do { s16x4 l0, l1, l2, l3, h0, h1, h2, h3; constexpr int b_ = VB * SHM_V + v_rd_off(d0, 0, 0); \
        TRRD(l0, b_); TRRD(h0, b_ + 2048); TRRD(l1, b_ + 4096); TRRD(h1, b_ + 6144); TRRD(l2, b_ + 8192); TRRD(h2, b_ + 10240); TRRD(l3, b_ + 12288); TRRD(h3, b_ + 14336); \
        asm volatile("s_waitcnt lgkmcnt(0)" ::: "memory"); SBAR();   \
        o[d0] = __builtin_amdgcn_mfma_f32_32x32x16_bf16(pa0, (bf16x8){l0[0], l0[1], l0[2], l0[3], h0[0], h0[1], h0[2], h0[3]}, o[d0], 0, 0, 0);   \
        o[d0] = __builtin_amdgcn_mfma_f32_32x32x16_bf16(pa1, (bf16x8){l1[0], l1[1], l1[2], l1[3], h1[0], h1[1], h1[2], h1[3]}, o[d0], 0, 0, 0);   \
        o[d0] = __builtin_amdgcn_mfma_f32_32x32x16_bf16(pa2, (bf16x8){l2[0], l2[1], l2[2], l2[3], h2[0], h2[1], h2[2], h2[3]}, o[d0], 0, 0, 0);   \
        o[d0] = __builtin_amdgcn_mfma_f32_32x32x16_bf16(pa3, (bf16x8){l3[0], l3[1], l3[2], l3[3], h3[0], h3[1], h3[2], h3[3]}, o[d0], 0, 0, 0); } while (0)
    PV_D0(0); PV_D0(1); PV_D0(2); PV_D0(3);
#undef PV_D0
#undef TRRD
}

struct Ctx { const bf16_t* proj; const bf16_t* mkv; bf16_t* og; const float* negc; const float* outg; };
constexpr int NFOX = 64 * 8, NMEMB = 64 * 8;
__device__ __forceinline__ bool is_fox(int id) { return id < NFOX; }
__device__ __forceinline__ void dec(int id, int& b, int& h, int& qb) { const int m = id & (NFOX - 1), bh = m >> 3; qb = m & 7; b = bh >> 2; h = bh & 3; }
__device__ __forceinline__ int queue_id(int x, int i) { if (i < 64) return (8 * x + (i & 7)) * 8 + (7 - (i >> 3)); const int m = i - 64; return NFOX + (8 * x + (m >> 3)) * 8 + (m & 7); }
__device__ __forceinline__ int bin_len(int j) { return j == 3 ? 7 : 3; }
__device__ __forceinline__ int bin_id(int j, int f, int s) {
    if (s < 2) { const int qb = (j == 0) ? (s == 0 ? 7 : 4) : (j == 1) ? (s == 0 ? 6 : 5) : (j == 2) ? (s == 0 ? 3 : 2) : (s == 0 ? 1 : 0); return f * 8 + qb; }
    return NFOX + f * 8 + (j == 3 ? 3 + (s - 2) : j);
}
__device__ __forceinline__ void kv_of(const Ctx& c, int id, const char*& K, const char*& V, int& ldkv) {
    int b, h, qb; dec(id, b, h, qb);
    if (is_fox(id)) { const bf16_t* pb = c.proj + (size_t)b * SEQ * LDP; K = (const char*)(pb + C_FK + h * 128); V = (const char*)(pb + C_FV + h * 128); ldkv = LDP; }
    else { const bf16_t* kvb = c.mkv + (size_t)b * MEMT * 1024; K = (const char*)(kvb + h * 128); V = (const char*)(kvb + 512 + h * 128); ldkv = 1024; }
}
__device__ __forceinline__ const char* q_of(const Ctx& c, int id) {
    int b, h, qb; dec(id, b, h, qb);
    return (const char*)(c.proj + ((size_t)b * SEQ + (size_t)qb * 256) * LDP + (is_fox(id) ? C_FQ : C_MQ) + h * 128);
}
struct Seam { bf16x8 qr[8]; bf16x8 st_v0, st_v1, st_k0, st_k1; };
#define VMW() asm volatile("s_waitcnt vmcnt(0)" ::: "memory")
#define VMWN(n) asm volatile("s_waitcnt vmcnt(%0)" :: "i"(n) : "memory")
#define LD16(base, voff) (*reinterpret_cast<const bf16x8*>((base) + (voff)))
#define SLOAD_H(Kp, Vp, ld, o0, o1, k0) do { const size_t tb_ = (size_t)(k0) * (ld) * 2; S.st_v0 = LD16((Vp) + tb_, o0); S.st_v1 = LD16((Vp) + tb_, o1); S.st_k0 = LD16((Kp) + tb_, o0); S.st_k1 = LD16((Kp) + tb_, o1); } while (0)
#define SWRITE_HK(bf) do { *(bf16x8*)(K_lds + (bf) * SHM_K + kws) = S.st_k0; *(bf16x8*)(K_lds + (bf) * SHM_K + kws + 32 * 256) = S.st_k1; } while (0)
#define SWRITE_HV(bf) do { *(bf16x8*)(V_lds + (bf) * SHM_V + vst0) = S.st_v0; *(bf16x8*)(V_lds + (bf) * SHM_V + vst1) = S.st_v1; } while (0)
#define SWRITE_H(bf) do { SWRITE_HV(bf); SWRITE_HK(bf); } while (0)
__device__ __forceinline__ void load_q(Seam& S, const char* Qb, int wid, int r32, int hi) {
    const unsigned qo = (unsigned)(((wid * QBLK + r32) * LDP + hi * 8) * 2);
#pragma unroll
    for (int d0 = 0; d0 < 8; ++d0) S.qr[d0] = LD16(Qb, qo + d0 * 32);
}
__device__ __forceinline__ void prime(const Ctx& c, int id, char* lds, Seam& S) {
    const int tid = threadIdx.x, wid = __builtin_amdgcn_readfirstlane(tid >> 6), lane = tid & 63, r32 = lane & 31, hi = lane >> 5;
    const int sr = tid >> 4, sc = (tid & 15) * 8, kws = KSWZ(sr, sc * 2); char* K_lds = lds + 2 * SHM_V;
    load_q(S, q_of(c, id), wid, r32, hi);
    const char* Kh; const char* Vh; int ldkv; kv_of(c, id, Kh, Vh, ldkv);
    const unsigned o0 = (unsigned)((sr * ldkv + sc) * 2), o1 = o0 + (unsigned)(32 * ldkv * 2);
    SLOAD_H(Kh, Vh, ldkv, o0, o1, 0); VMW(); SWRITE_HK(0);
    __syncthreads();
}
template <bool FOX>
__device__ __forceinline__ void block(const Ctx& c, const int id, const int nid, char* lds, Seam& S) {
    int tid = threadIdx.x; asm volatile("" : "+v"(tid));
    const int wid = __builtin_amdgcn_readfirstlane(tid >> 6), lane = tid & 63, r32 = lane & 31, hi = lane >> 5;
    int cb, ch, cqb; dec(id, cb, ch, cqb);
    const int P0 = FOX ? cqb * 256 : 0;
    const int NT = FOX ? (P0 + QB) / KVBLK : MEMT / KVBLK;
    const int qlo = P0 + wid * QBLK, qm = qlo + r32 - 4 * hi;
    char* V_lds = lds; char* K_lds = lds + 2 * SHM_V;
    float* ws = (float*)(lds + LDS_WS) + wid * 64; float* li_l = ws, * al_l = ws + 32;
    const LAS float* negs = (const LAS float*)(uintptr_t)((unsigned)(uintptr_t)lds + LDS_NEGC) + 4 * hi;
    if (FOX) { const float* ng = c.negc + (size_t)(cb * 4 + ch) * SEQ; LAS float* nd = (LAS float*)(uintptr_t)((unsigned)(uintptr_t)lds + LDS_NEGC);
        const int n = P0 + QB; for (int i = tid * 4; i < n; i += 2048) *(LAS f32x4*)(nd + i) = *(const f32x4*)(ng + i); }
    if (FOX) __syncthreads();
    float m_reg = -1e30f, l_reg = 0; f32x16 o[4] = {};
    const int sr = tid >> 4, sc = (tid & 15) * 8, vst0 = v_st(sr, sc), vst1 = v_st(32 + sr, sc), kws = KSWZ(sr, sc * 2);
    const int vb0 = (int)(uintptr_t)V_lds + v_rd_base(lane);
    const char* Kh; const char* Vh; int ldkv; kv_of(c, id, Kh, Vh, ldkv);
    const unsigned o0 = (unsigned)((sr * ldkv + sc) * 2), o1 = o0 + (unsigned)(32 * ldkv * 2);
#define RESC(a) do { if (__any((a) < 1.f)) { if (hi == 0) al_l[r32] = (a); asm volatile("s_waitcnt lgkmcnt(0)" ::: "memory");              \
                     for (int d_ = 0; d_ < 4; ++d_) for (int r = 0; r < 16; ++r) o[d_][r] *= al_l[crow(r, hi)]; } } while (0)
#define KBASE(t) ((t) * KVBLK)
#define MASKT(P0_, P1_, t) do { if (FOX) { const int kb_ = KBASE(t); if (kb_ + KVBLK - 1 > qlo) mask_tile(P0_, P1_, qm - kb_); } } while (0)
#define SEAM_K0() do { VMWN(8); SWRITE_HK(0); SBAR(); } while (0)
    f32x16 pA0, pA1, pB0, pB1; float mnA, mnB, alA, alB; bf16x8 pa0, pa1, pa2, pa3;
    SWRITE_HV(0); SBAR();
    if (NT > 1) { SLOAD_H(Kh, Vh, ldkv, o0, o1, KBASE(1)); }
    SBAR(); qkt<0, FOX>(pA0, pA1, K_lds, r32, hi, S.qr, negs + KBASE(0));
    MASKT(pA0, pA1, 0); partialSM(pA0, pA1, m_reg, mnA, alA);
    if (NT > 1) { VMW(); SWRITE_H(1); }
    __syncthreads();
#define HALF_STEP(PX0, PX1, mnX, alX, PY0, PY1, alY, t, KB, VB, SB) do {                                                      \
        SBAR(); qkt<KB, FOX>(PX0, PX1, K_lds, r32, hi, S.qr, negs + KBASE(t));                                                \
        finishSM(PY0, PY1, alY, l_reg, pa0, pa1, pa2, pa3); SBAR();                                                           \
        if ((t) + 1 < NT) { SLOAD_H(Kh, Vh, ldkv, o0, o1, KBASE((t) + 1)); SBAR(); }                                          \
        pv_tile<VB>(o, vb0, pa0, pa1, pa2, pa3); MASKT(PX0, PX1, (t)); partialSM(PX0, PX1, m_reg, mnX, alX);                  \
        __syncthreads();                                                                                                      \
        if ((t) + 1 < NT) { VMW(); SWRITE_H(SB); }                                                                            \
        RESC(alX); __syncthreads(); } while (0)
    for (int t = 1; t + 1 < NT; t += 2) {
        HALF_STEP(pB0, pB1, mnB, alB, pA0, pA1, alA, t, 1, 0, 0);
        HALF_STEP(pA0, pA1, mnA, alA, pB0, pB1, alB, t + 1, 0, 1, 1);
    }
    SBAR(); qkt<1, FOX>(pB0, pB1, K_lds, r32, hi, S.qr, negs + KBASE(NT - 1)); SBAR();
    { const char* nK; const char* nV; int nld; kv_of(c, nid, nK, nV, nld);
      const unsigned n0 = (unsigned)((sr * nld + sc) * 2), n1 = n0 + (unsigned)(32 * nld * 2);
      SLOAD_H(nK, nV, nld, n0, n1, 0); SBAR();
      load_q(S, q_of(c, nid), wid, r32, hi); }
    SBAR();
    finishSM(pA0, pA1, alA, l_reg, pa0, pa1, pa2, pa3); SBAR();
    pv_tile<0>(o, vb0, pa0, pa1, pa2, pa3);
    MASKT(pB0, pB1, NT - 1); partialSM(pB0, pB1, m_reg, mnB, alB); __syncthreads(); RESC(alB);
    finishSM(pB0, pB1, alB, l_reg, pa0, pa1, pa2, pa3); SBAR(); pv_tile<1>(o, vb0, pa0, pa1, pa2, pa3);
    SBAR(); SEAM_K0();
    if (hi == 0) li_l[r32] = l_reg; asm volatile("s_waitcnt lgkmcnt(0)" ::: "memory");
    {
        const int head = (FOX ? 8 : 12) + ch;
        LAS float* stg = (LAS float*)(uintptr_t)((unsigned)(uintptr_t)lds + LDS_STG) + wid * (16 * SP);
        const int erow = lane >> 2, eq = lane & 3;
        unsigned eo = (unsigned)(erow * LDP + eq * 32), eo2 = (unsigned)(erow * DM + eq * 32);
        asm volatile("" : "+v"(eo), "+v"(eo2));
        const size_t row0 = (size_t)cb * SEQ + (size_t)cqb * 256 + wid * QBLK;
        const bf16_t* gbase = c.proj + row0 * LDP + (FOX ? C_FG : C_MG) + ch * 128;
        bf16_t* obase = c.og + row0 * DM + head * 128;
        const float* gnp = c.outg + head * 128 + eq * 32;
#pragma unroll
        for (int rd = 0; rd < 2; ++rd) {
#pragma unroll
            for (int rr = 0; rr < 8; ++rr) { const int r = rd * 8 + rr; const int lrow = (rr & 3) + 8 * (rr >> 2) + 4 * hi;
                const float rl = __builtin_amdgcn_rcpf(li_l[crow(r, hi)]);
#pragma unroll
                for (int d0 = 0; d0 < 4; ++d0) stg[lrow * SP + d0 * 32 + r32] = o[d0][r] * rl; }
            bf16x8 g[4];
#pragma unroll
            for (int q = 0; q < 4; ++q) g[q] = *(const bf16x8*)(gbase + (size_t)rd * 16 * LDP + eo + 8 * q);
            asm volatile("s_waitcnt lgkmcnt(0)" ::: "memory");
            f32x4 v[8]; float ss = 0.f;
#pragma unroll
            for (int q = 0; q < 8; ++q) { v[q] = *(const LAS f32x4*)(stg + erow * SP + eq * 32 + 4 * q); ss += (v[q][0] * v[q][0] + v[q][1] * v[q][1]) + (v[q][2] * v[q][2] + v[q][3] * v[q][3]); }
            ss += __shfl_xor(ss, 1); ss += __shfl_xor(ss, 2);
            const float rn = __builtin_amdgcn_rsqf(ss * (1.0f / 128.0f) + EPS);
            unsigned w[16];
#pragma unroll
            for (int q = 0; q < 8; ++q) { const f32x4 gq = *(const f32x4*)(gnp + 4 * q); float val[4];
#pragma unroll
                for (int e = 0; e < 4; ++e) { const float gt = bf2f((unsigned short)g[q >> 1][(q & 1) * 4 + e]); val[e] = v[q][e] * rn * gq[e] * __builtin_amdgcn_rcpf(1.0f + __expf(-gt)); }
                w[2 * q] = cvtpk(val[0], val[1]); w[2 * q + 1] = cvtpk(val[2], val[3]); }
            bf16_t* op = obase + (size_t)rd * 16 * DM + eo2;
#pragma unroll
            for (int q = 0; q < 4; ++q) *(u32x4*)(op + 8 * q) = (u32x4){w[4 * q], w[4 * q + 1], w[4 * q + 2], w[4 * q + 3]};
            asm volatile("s_waitcnt lgkmcnt(0)" ::: "memory");
        }
    }
    __syncthreads();
#undef RESC
#undef KBASE
#undef MASKT
#undef SEAM_K0
#undef HALF_STEP
}
#undef VMW
#undef VMWN
#undef LD16
#undef SLOAD_H
#undef SWRITE_HK
#undef SWRITE_HV
#undef SWRITE_H
}

namespace gla {
constexpr int LS = 72;
constexpr int O_W2 = 0, O_AB = 4096, O_GAIN = 4352, O_BL = 4864, O_QS = 5120, O_KS = 14336, O_KDT = 23552, O_VT = 32768, O_P = 51200, O_ST0 = 60416, O_ST1 = 78848, O_OUT = 97280, LDS_BYTES = 131072;
constexpr int OP = 132;
__device__ __forceinline__ int crow(int r, int hi) { return (r & 3) + 8 * (r >> 2) + 4 * hi; }
__device__ __forceinline__ unsigned short f2bf(float f) { unsigned u = __float_as_uint(f); return (unsigned short)((u + 0x7fffu + ((u >> 16) & 1u)) >> 16); }
__device__ __forceinline__ float bf2f(unsigned short b) { return __uint_as_float((unsigned)b << 16); }
typedef float f32x2_t __attribute__((ext_vector_type(2))); typedef __bf16 bf16x2_t __attribute__((ext_vector_type(2)));
__device__ __forceinline__ unsigned cvtpk(float lo, float hi) { f32x2_t v = {lo, hi}; bf16x2_t b = __builtin_convertvector(v, bf16x2_t); return __builtin_bit_cast(unsigned, b); }
__device__ __forceinline__ bf16x8 frag(const LAS unsigned char* base, int row, int kk) { return *(const LAS bf16x8*)(base + row * (LS * 2) + kk * 2); }
__device__ __forceinline__ unsigned short bf1(float f) { return (unsigned short)cvtpk(f, 0.f); }
template <int CTRL> __device__ __forceinline__ float dpp0(float v) { return __builtin_bit_cast(float, __builtin_amdgcn_update_dpp(0, __builtin_bit_cast(int, v), CTRL, 0xf, 0xf, false)); }
__device__ __forceinline__ float wave_scan(float v, int lane) {
    v += dpp0<0x111>(v); v += dpp0<0x112>(v); v += dpp0<0x114>(v); v += dpp0<0x118>(v);
    const float s15 = __builtin_bit_cast(float, __builtin_amdgcn_readlane(__builtin_bit_cast(int, v), 15));
    const float s31 = __builtin_bit_cast(float, __builtin_amdgcn_readlane(__builtin_bit_cast(int, v), 31));
    const float s47 = __builtin_bit_cast(float, __builtin_amdgcn_readlane(__builtin_bit_cast(int, v), 47));
    return v + ((lane >= 16 ? s15 : 0.f) + (lane >= 32 ? s31 : 0.f) + (lane >= 48 ? s47 : 0.f));
}

__device__ __forceinline__ void run(LAS unsigned char* lds, int b, int h, const bf16_t* proj, const float* gates, const float* w2, const float* ab, const float* ong, bf16_t* og) {
    const int tid = threadIdx.x, wid = __builtin_amdgcn_readfirstlane(tid >> 6), lane = tid & 63, r32 = lane & 31, hi = lane >> 5;
    LAS float* w2_s = (LAS float*)(lds + O_W2); LAS float* ab_s = (LAS float*)(lds + O_AB); LAS float* gain_s = (LAS float*)(lds + O_GAIN); LAS float* bl_s = (LAS float*)(lds + O_BL);
    LAS float* out_s = (LAS float*)(lds + O_OUT);
    for (int i = tid; i < 1024; i += 512) w2_s[i] = w2[(i >> 6) * 512 + h * 64 + (i & 63)];
    if (tid < 64) ab_s[tid] = ab[h * 64 + tid];
    if (tid < 128) gain_s[tid] = ong[h * 128 + tid];
    for (int i = tid * 16; i < 128 * LS * 2; i += 512 * 16) *(LAS u32x4*)(lds + O_ST0 + i) = (u32x4){0u, 0u, 0u, 0u};
    const int ib = wid >> 2, db = wid & 3;
    const int dvb = wid >> 1, dkb = wid & 1;
    f32x16 accS = {};
    const int erow = tid >> 3, ecg = tid & 7;
    const size_t rowb = (size_t)b * SEQ;
    const bf16_t* pl = proj + (rowb + lane) * LDP;
    const float* gl = gates + (rowb + lane) * 32;
    const bf16_t* pg = proj + (rowb + erow) * LDP + C_GG + h * 128 + ecg * 16;
    bf16x8 qv = *(const bf16x8*)(pl + C_GQ + h * 64 + 8 * wid), kv = *(const bf16x8*)(pl + C_GK + h * 64 + 8 * wid);
    bf16x8 v0 = *(const bf16x8*)(pl + C_GV + h * 128 + 16 * wid), v1 = *(const bf16x8*)(pl + C_GV + h * 128 + 16 * wid + 8);
    f32x4 ga0 = *(const f32x4*)(gl), ga1 = *(const f32x4*)(gl + 4), ga2 = *(const f32x4*)(gl + 8), ga3 = *(const f32x4*)(gl + 12);
    bf16x8 gt0 = *(const bf16x8*)(pg), gt1 = *(const bf16x8*)(pg + 8);
    __syncthreads();
    for (int n = 0; n < SEQ / 64; ++n) {
        const size_t r0 = rowb + (size_t)n * 64;
        {
            float z[8];
            { const f32x4 a0 = *(const LAS f32x4*)(ab_s + 8 * wid), a1 = *(const LAS f32x4*)(ab_s + 8 * wid + 4);
              z[0] = a0[0]; z[1] = a0[1]; z[2] = a0[2]; z[3] = a0[3]; z[4] = a1[0]; z[5] = a1[1]; z[6] = a1[2]; z[7] = a1[3]; }
            const float gaf[16] = {ga0[0], ga0[1], ga0[2], ga0[3], ga1[0], ga1[1], ga1[2], ga1[3], ga2[0], ga2[1], ga2[2], ga2[3], ga3[0], ga3[1], ga3[2], ga3[3]};
#pragma unroll
            for (int r = 0; r < 16; ++r) { const f32x4 w0 = *(const LAS f32x4*)(w2_s + r * 64 + 8 * wid), w1 = *(const LAS f32x4*)(w2_s + r * 64 + 8 * wid + 4);
                z[0] = fmaf(gaf[r], w0[0], z[0]); z[1] = fmaf(gaf[r], w0[1], z[1]); z[2] = fmaf(gaf[r], w0[2], z[2]); z[3] = fmaf(gaf[r], w0[3], z[3]);
                z[4] = fmaf(gaf[r], w1[0], z[4]); z[5] = fmaf(gaf[r], w1[1], z[5]); z[6] = fmaf(gaf[r], w1[2], z[6]); z[7] = fmaf(gaf[r], w1[3], z[7]); }
            float b2[8];
#pragma unroll
            for (int j = 0; j < 8; ++j) b2[j] = (fminf(z[j], 0.f) - __logf(1.0f + __expf(-fabsf(z[j])))) * (LOG2E / 16.0f);
#pragma unroll
            for (int j = 0; j < 8; ++j) b2[j] = wave_scan(b2[j], lane);
            float qf[8], kf[8];
#pragma unroll
            for (int j = 0; j < 8; ++j) { const float bl = __builtin_bit_cast(float, __builtin_amdgcn_readlane(__builtin_bit_cast(int, b2[j]), 63)); if (lane == 63) bl_s[8 * wid + j] = bl;
                const float q = bf2f((unsigned short)qv[j]), k = bf2f((unsigned short)kv[j]);
                qf[j] = q * 0.125f * __builtin_amdgcn_exp2f(b2[j]); kf[j] = k * __builtin_amdgcn_exp2f(-b2[j]);
                *(LAS unsigned short*)(lds + O_KDT + (8 * wid + j) * (LS * 2) + lane * 2) = bf1(k * __builtin_amdgcn_exp2f(bl - b2[j]));
                *(LAS unsigned short*)(lds + O_VT + (16 * wid + j) * (LS * 2) + lane * 2) = (unsigned short)v0[j];
                *(LAS unsigned short*)(lds + O_VT + (16 * wid + 8 + j) * (LS * 2) + lane * 2) = (unsigned short)v1[j]; }
            *(LAS u32x4*)(lds + O_QS + lane * (LS * 2) + 16 * wid) = (u32x4){cvtpk(qf[0], qf[1]), cvtpk(qf[2], qf[3]), cvtpk(qf[4], qf[5]), cvtpk(qf[6], qf[7])};
            *(LAS u32x4*)(lds + O_KS + lane * (LS * 2) + 16 * wid) = (u32x4){cvtpk(kf[0], kf[1]), cvtpk(kf[2], kf[3]), cvtpk(kf[4], kf[5]), cvtpk(kf[6], kf[7])};
        }
        if (n + 1 < SEQ / 64) { const bf16_t* pn = pl + (size_t)(n + 1) * 64 * LDP; const float* gn = gl + (size_t)(n + 1) * 64 * 32;
            qv = *(const bf16x8*)(pn + C_GQ + h * 64 + 8 * wid); kv = *(const bf16x8*)(pn + C_GK + h * 64 + 8 * wid);
            v0 = *(const bf16x8*)(pn + C_GV + h * 128 + 16 * wid); v1 = *(const bf16x8*)(pn + C_GV + h * 128 + 16 * wid + 8);
            ga0 = *(const f32x4*)(gn); ga1 = *(const f32x4*)(gn + 4); ga2 = *(const f32x4*)(gn + 8); ga3 = *(const f32x4*)(gn + 12); }
        asm volatile("s_waitcnt lgkmcnt(0)" ::: "memory"); __builtin_amdgcn_s_barrier(); asm volatile("" ::: "memory");
        const LAS unsigned char* STc = lds + ((n & 1) ? O_ST1 : O_ST0); LAS unsigned char* STn = lds + ((n & 1) ? O_ST0 : O_ST1);
        f32x16 acc = {};
        if (wid < 3) { const int sib = wid > 0, sjb = wid > 1; f32x16 sc = {};
#pragma unroll
            for (int s = 0; s < 4; ++s) sc = __builtin_amdgcn_mfma_f32_32x32x16_bf16(frag(lds + O_QS, sib * 32 + r32, s * 16 + hi * 8), frag(lds + O_KS, sjb * 32 + r32, s * 16 + hi * 8), sc, 0, 0, 0);
#pragma unroll
            for (int r = 0; r < 16; ++r) { const int i = sib * 32 + crow(r, hi), j = sjb * 32 + r32; *(LAS unsigned short*)(lds + O_P + i * (LS * 2) + j * 2) = bf1(i >= j ? sc[r] : 0.f); } }
#pragma unroll
        for (int s = 0; s < 4; ++s) acc = __builtin_amdgcn_mfma_f32_32x32x16_bf16(frag(lds + O_QS, ib * 32 + r32, s * 16 + hi * 8), frag(STc, db * 32 + r32, s * 16 + hi * 8), acc, 0, 0, 0);
        { const float dec = __builtin_amdgcn_exp2f(bl_s[dkb * 32 + r32]);
#pragma unroll
          for (int r = 0; r < 16; ++r) accS[r] *= dec;
#pragma unroll
          for (int s = 0; s < 4; ++s) accS = __builtin_amdgcn_mfma_f32_32x32x16_bf16(frag(lds + O_VT, dvb * 32 + r32, s * 16 + hi * 8), frag(lds + O_KDT, dkb * 32 + r32, s * 16 + hi * 8), accS, 0, 0, 0);
#pragma unroll
          for (int r = 0; r < 16; ++r) *(LAS unsigned short*)(STn + (dvb * 32 + crow(r, hi)) * (LS * 2) + (dkb * 32 + r32) * 2) = bf1(accS[r]); }
        asm volatile("s_waitcnt lgkmcnt(0)" ::: "memory"); __builtin_amdgcn_s_barrier(); asm volatile("" ::: "memory");
#pragma unroll
        for (int s = 0; s < 4; ++s) if (ib == 1 || s < 2) acc = __builtin_amdgcn_mfma_f32_32x32x16_bf16(frag(lds + O_P, ib * 32 + r32, s * 16 + hi * 8), frag(lds + O_VT, db * 32 + r32, s * 16 + hi * 8), acc, 0, 0, 0);
#pragma unroll
        for (int r = 0; r < 16; ++r) out_s[(ib * 32 + crow(r, hi)) * OP + db * 32 + r32] = acc[r];
        asm volatile("s_waitcnt lgkmcnt(0)" ::: "memory"); __builtin_amdgcn_s_barrier(); asm volatile("" ::: "memory");
        {
            f32x4 o4[4]; float ss = 0.f;
#pragma unroll
            for (int q = 0; q < 4; ++q) { o4[q] = *(const LAS f32x4*)(out_s + erow * OP + ecg * 16 + 4 * q); ss += (o4[q][0] * o4[q][0] + o4[q][1] * o4[q][1]) + (o4[q][2] * o4[q][2] + o4[q][3] * o4[q][3]); }
            ss += __shfl_xor(ss, 1); ss += __shfl_xor(ss, 2); ss += __shfl_xor(ss, 4);
            const float rn = __builtin_amdgcn_rsqf(ss * (1.0f / 128.0f) + EPS);
            unsigned w[8];
#pragma unroll
            for (int q = 0; q < 4; ++q) { const f32x4 gq = *(const LAS f32x4*)(gain_s + ecg * 16 + 4 * q); float val[4];
#pragma unroll
                for (int e = 0; e < 4; ++e) { const int c = 4 * q + e; const float gt = bf2f((unsigned short)(c < 8 ? gt0[c & 7] : gt1[c & 7]));
                    val[e] = o4[q][e] * rn * gq[e] * gt * __builtin_amdgcn_rcpf(1.0f + __expf(-gt)); }
                w[2 * q] = cvtpk(val[0], val[1]); w[2 * q + 1] = cvtpk(val[2], val[3]); }
            bf16_t* op = og + (r0 + erow) * DM + h * 128 + ecg * 16;
            *(u32x4*)op = (u32x4){w[0], w[1], w[2], w[3]}; *(u32x4*)(op + 8) = (u32x4){w[4], w[5], w[6], w[7]};
            if (n + 1 < SEQ / 64) { const bf16_t* pgn = pg + (size_t)(n + 1) * 64 * LDP; gt0 = *(const bf16x8*)(pgn); gt1 = *(const bf16x8*)(pgn + 8); }
        }
    }
    __syncthreads();
}
}


#define XB_TMO      128
#define XB_XCNT(j)  (256  + 64 * (j))
#define XB_XSUB(j)  (1280 + 64 * (j))
#define XB_XGEN(j)  (2304 + 64 * (j))
#define XB_TOP      3328
#define XB_TOPGEN   3392
#define XCD_BAR_WORDS 3456
#define XB_SPIN_CAP (1u << 18)
__device__ __forceinline__ unsigned xb_ld(unsigned* p)              { return __hip_atomic_load(p, __ATOMIC_RELAXED, __HIP_MEMORY_SCOPE_AGENT); }
__device__ __forceinline__ unsigned xb_add(unsigned* p, unsigned v) { return __hip_atomic_fetch_add(p, v, __ATOMIC_RELAXED, __HIP_MEMORY_SCOPE_AGENT); }
__device__ __forceinline__ unsigned xb_xcc_id() { return (unsigned)__builtin_amdgcn_s_getreg((3 << 11) | 20) & 0xFu; }
#define XB_SPIN(cond, bar) do { unsigned _sp = 0; while (cond) { __builtin_amdgcn_s_sleep(1); \
    if ((++_sp & 255u) == 0u) { if (xb_ld(&(bar)[XB_TMO])) break; if (_sp > XB_SPIN_CAP) { atomicAdd(&(bar)[XB_TMO], 1u); break; } } } } while (0)
struct XcdBarrier { unsigned* bar; unsigned x; volatile LAS unsigned* st; };
__device__ __forceinline__ XcdBarrier xcd_barrier_post(unsigned* bar, volatile LAS unsigned* st) {
    XcdBarrier b; b.bar = bar; b.x = xb_xcc_id(); b.st = st;
    if (threadIdx.x == 0) (void)xb_add(&bar[XB_XCNT(b.x)], 1u);
    return b;
}
__device__ __forceinline__ void xcd_barrier_complete(unsigned* bar, unsigned x, unsigned& nloc, unsigned& nx) {
    const unsigned G = gridDim.x * gridDim.y * gridDim.z;
    unsigned sum, cnt, mine, sp = 0u;
    for (;;) {
        sum = 0u; cnt = 0u; mine = 0u;
#pragma unroll
        for (unsigned j = 0; j < 16; ++j) { const unsigned c = xb_ld(&bar[XB_XCNT(j)]); sum += c; cnt += (c > 0u) ? 1u : 0u; mine = (j == x) ? c : mine; }
        if (sum == G) break;
        __builtin_amdgcn_s_sleep(1);
        if ((++sp & 255u) == 0u) { if (xb_ld(&bar[XB_TMO])) break; if (sp > XB_SPIN_CAP) { atomicAdd(&bar[XB_TMO], 1u); break; } }
    }
    nloc = mine > 0u ? mine : 1u; nx = cnt > 0u ? cnt : 1u;
}
__device__ __forceinline__ void xcd_barrier(const XcdBarrier& b) {
    asm volatile("s_waitcnt vmcnt(0)" ::: "memory");
    __syncthreads();
    if (threadIdx.x == 0) {
        unsigned* bar = b.bar;
        __builtin_amdgcn_s_waitcnt(0);
        unsigned nloc = b.st[0], nx = b.st[1];
        if (nloc == 0u) { xcd_barrier_complete(bar, b.x, nloc, nx); b.st[0] = nloc; b.st[1] = nx; }
        const unsigned old = xb_add(&bar[XB_XSUB(b.x)], 1u);
        const unsigned gen = old / nloc;
        if (old + 1u == (gen + 1u) * nloc) {
            __builtin_amdgcn_fence(__ATOMIC_RELEASE, "agent");
            asm volatile("s_waitcnt vmcnt(0)" ::: "memory");
            const unsigned og = xb_add(&bar[XB_TOP], 1u);
            const unsigned tg = og / nx;
            if (og + 1u == (tg + 1u) * nx) xb_add(&bar[XB_TOPGEN], 1u);
            else XB_SPIN(xb_ld(&bar[XB_TOPGEN]) == tg, bar);
            __builtin_amdgcn_fence(__ATOMIC_ACQUIRE, "agent");
            xb_add(&bar[XB_XGEN(b.x)], 1u);
            asm volatile("s_waitcnt vmcnt(0)" ::: "memory");
        } else {
            XB_SPIN(xb_ld(&bar[XB_XGEN(b.x)]) == gen, bar);
            __builtin_amdgcn_fence(__ATOMIC_ACQUIRE, "agent");
            asm volatile("s_waitcnt vmcnt(0)" ::: "memory");
        }
    }
    __syncthreads();
}

constexpr int NWAVES = 8;
constexpr int LDS_BYTES = 147456;
constexpr int MISC_OFF = 143360;
static_assert(pg8::STAGE_BYTES <= MISC_OFF && att::LDS_BYTES <= MISC_OFF && gla::LDS_BYTES <= MISC_OFF && MISC_OFF + 256 <= LDS_BYTES, "LDS map");

struct Args { const float* in[18]; float* out; unsigned char* ws; int ph_lo, ph_hi; };

__device__ __forceinline__ unsigned short f2bf(float f) { unsigned u = __float_as_uint(f); return (unsigned short)((u + 0x7fffu + ((u >> 16) & 1u)) >> 16); }
__device__ __forceinline__ unsigned pk2(float lo, float hi) { return (unsigned)f2bf(lo) | ((unsigned)f2bf(hi) << 16); }
__device__ __forceinline__ float wave_sum(float v) {
#pragma unroll
    for (int o = 1; o < 64; o <<= 1) v += __shfl_xor(v, o);
    return v;
}
__device__ __forceinline__ int win_src(int n) {
    if (n < 3072) return n;
    if (n < 5120) return n + 16;
    if (n < 6144) return n + 20;
    if (n < 6160) return 3072 + (n - 6144);
    if (n < 6164) return 5136 + (n - 6160);
    return -1;
}
template <bool WIN>
__device__ __forceinline__ void transpose_item(const float* W, int K, int N, bf16_t* WT, const float* kgain, LAS float* scr, int item, int nblk, int lane) {
    const int kb = item / nblk, nb = item % nblk, k0 = 64 * kb, n0 = 32 * nb;
    const int nd = n0 + (lane & 31); const int sc = WIN ? win_src(nd) : nd;
    float v[32];
    const float* wp = W + (size_t)(k0 + (lane >> 5)) * N + (sc >= 0 ? sc : 0);
#pragma unroll
    for (int i = 0; i < 32; ++i) v[i] = __builtin_nontemporal_load(&wp[(size_t)(2 * i) * N]);
#pragma unroll
    for (int i = 0; i < 32; ++i) { const int kk = 2 * i + (lane >> 5); float t_ = sc >= 0 ? v[i] : 0.f; if (kgain) t_ *= kgain[k0 + kk]; scr[kk * 33 + (lane & 31)] = t_; }
    asm volatile("s_waitcnt lgkmcnt(0)" ::: "memory");
    const int c = lane & 7;
#pragma unroll
    for (int j = 0; j < 4; ++j) { const int n = (lane >> 3) + 8 * j; const LAS float* s = scr + (8 * c) * 33 + n;
        u32x4 o; o.x = pk2(s[0 * 33], s[1 * 33]); o.y = pk2(s[2 * 33], s[3 * 33]); o.z = pk2(s[4 * 33], s[5 * 33]); o.w = pk2(s[6 * 33], s[7 * 33]);
        *(u32x4*)(WT + (size_t)(n0 + n) * K + k0 + 8 * c) = o; }
    asm volatile("s_waitcnt lgkmcnt(0)" ::: "memory");
}
__device__ __forceinline__ void rms_row_to_bf16(const float* xrow, const float* g, bf16_t* orow, int lane) {
    const f32x4* xr = (const f32x4*)xrow + 2 * lane; const f32x4* gr = (const f32x4*)g + 2 * lane;
    f32x4 v[8]; float s = 0.f;
#pragma unroll
    for (int j = 0; j < 4; ++j) { v[2 * j] = __builtin_nontemporal_load(&xr[128 * j]); v[2 * j + 1] = __builtin_nontemporal_load(&xr[128 * j + 1]); }
#pragma unroll
    for (int j = 0; j < 8; ++j) s += (v[j].x * v[j].x + v[j].y * v[j].y) + (v[j].z * v[j].z + v[j].w * v[j].w);
    const float r = 1.0f / sqrtf(wave_sum(s) * (1.0f / DM) + EPS);
    u32x4* o16 = (u32x4*)orow + lane;
#pragma unroll
    for (int j = 0; j < 4; ++j) { const f32x4 g0 = gr[128 * j], g1 = gr[128 * j + 1]; const f32x4 a = v[2 * j], c = v[2 * j + 1]; u32x4 w;
        w.x = pk2(a.x * r * g0.x, a.y * r * g0.y); w.y = pk2(a.z * r * g0.z, a.w * r * g0.w); w.z = pk2(c.x * r * g1.x, c.y * r * g1.y); w.w = pk2(c.z * r * g1.z, c.w * r * g1.w);
        o16[64 * j] = w; }
}
__device__ __forceinline__ bf16x8 hn_load(const bf16_t* p, int lane) { return *(const bf16x8*)(p + lane * 8); }
__device__ __forceinline__ void hn_finish(bf16_t* p, bf16x8 v, const float* g, int lane) {
    float f[8]; float ss = 0.f;
#pragma unroll
    for (int e = 0; e < 8; ++e) { f[e] = __uint_as_float((unsigned)(unsigned short)v[e] << 16); ss += f[e] * f[e]; }
    ss += __shfl_xor(ss, 1); ss += __shfl_xor(ss, 2); ss += __shfl_xor(ss, 4); ss += __shfl_xor(ss, 8);
    const float r = __builtin_amdgcn_rsqf(ss * (1.0f / 128.0f) + EPS);
    const f32x4 g0 = *(const f32x4*)(g + (lane & 15) * 8), g1 = *(const f32x4*)(g + (lane & 15) * 8 + 4);
    u32x4 w; w.x = pk2(f[0] * r * g0[0], f[1] * r * g0[1]); w.y = pk2(f[2] * r * g0[2], f[3] * r * g0[3]); w.z = pk2(f[4] * r * g1[0], f[5] * r * g1[1]); w.w = pk2(f[6] * r * g1[2], f[7] * r * g1[3]);
    *(u32x4*)(p + lane * 8) = w;
}
__device__ __forceinline__ float logsig(float z) { return fminf(z, 0.f) - __logf(1.0f + __expf(-fabsf(z))); }


constexpr int LW_OUT = 32 * 64, LW_UP = 32 * 256, LW_DN = 128 * 64, LW_TOTAL = LW_OUT + LW_UP + LW_DN, LW_EARLY = 64 * NWAVES * 11;
__device__ __forceinline__ void late_weights(int it0, int it1, int w, int nw, const float* w_out, const float* w_up, const float* w_dn, const float* mlp_g, bf16_t* Wout_t, bf16_t* Wup_t, bf16_t* Wdn_t, LAS float* scr, int lane) {
    for (int it = it0 + w; it < it1; it += nw) {
        int r = it;
        if (r < LW_OUT) { transpose_item<false>(w_out, DM, DM, Wout_t, nullptr, scr, r, 64, lane); continue; } r -= LW_OUT;
        if (r < LW_UP) { transpose_item<false>(w_up, DM, DFF, Wup_t, mlp_g, scr, r, 256, lane); continue; } r -= LW_UP;
        transpose_item<false>(w_dn, DFF, DM, Wdn_t, nullptr, scr, r, 64, lane);
    }
}

__global__ void __launch_bounds__(NWAVES * 64, 2) hymba_fwd(Args args) {
    extern __shared__ __attribute__((aligned(16))) unsigned char lds_raw[];
    LAS unsigned char* lds = (LAS unsigned char*)lds_raw;
    cg::grid_group grid = cg::this_grid();
    const int tid = threadIdx.x, lane = tid & 63, wave = __builtin_amdgcn_readfirstlane(tid >> 6);
    const int G = gridDim.x, bx = blockIdx.x;
    const int lo = args.ph_lo, hi = args.ph_hi;
    unsigned char* ws = args.ws;
    const float* x = args.in[0]; const float* mem = args.in[1]; const float* attn_g = args.in[2]; const float* w_in = args.in[3];
    const float* gla_w2 = args.in[4]; const float* gla_ab = args.in[5]; const float* fox_fb = args.in[6]; const float* fox_qg = args.in[7]; const float* fox_kg = args.in[8];
    const float* mem_g = args.in[9]; const float* w_mkv = args.in[10]; const float* mem_qg = args.in[11]; const float* mem_kg = args.in[12]; const float* out_g = args.in[13];
    const float* w_out = args.in[14]; const float* mlp_g = args.in[15]; const float* w_up = args.in[16]; const float* w_dn = args.in[17];
    float* out = args.out;
    float* rowsq = (float*)(ws + WS_ROWSQ); float* negc = (float*)(ws + WS_NEGC); float* gates = (float*)(ws + WS_GATES);
    bf16_t* Win_t = (bf16_t*)(ws + WS_WIN); bf16_t* Wout_t = (bf16_t*)(ws + WS_WOUT); bf16_t* Wup_t = (bf16_t*)(ws + WS_WUP); bf16_t* Wdn_t = (bf16_t*)(ws + WS_WDN); bf16_t* Wmkv_t = (bf16_t*)(ws + WS_WMKV);
    bf16_t* MN = (bf16_t*)(ws + WS_MN); bf16_t* MKV = (bf16_t*)(ws + WS_MKV); bf16_t* XN = (bf16_t*)(ws + WS_XN); bf16_t* OG = XN; bf16_t* HB = (bf16_t*)(ws + WS_HB);
    bf16_t* PROJ = (bf16_t*)(ws + WS_BIG); bf16_t* UB = PROJ;
#ifndef PHMASK
#define PHMASK 127
#endif
#define IN(k) (((PHMASK >> (k)) & 1) && lo <= (k) && (k) < hi)
    volatile LAS unsigned* MISC = (volatile LAS unsigned*)(lds + MISC_OFF);
    if (tid < 2) MISC[tid] = 0u;
    __syncthreads();
    XcdBarrier xbar; xbar.bar = (unsigned*)(ws + WS_CTL); xbar.x = 0; xbar.st = MISC;
#define SEAM(k) do { if ((k) != 2 && IN(k) && IN((k) + 1)) { if ((k) == 0) grid.sync(); else xcd_barrier(xbar); } } while (0)
#ifndef REP_PHASE
#define REP_PHASE -1
#endif
#define REPS(k) for (int rep_ = 0; rep_ < (REP_PHASE == (k) ? 2 : 1); ++rep_)

    if (IN(0)) REPS(0) {
        const int gw = bx * NWAVES + wave, NGW = G * NWAVES;
        for (int i = bx * 512 + tid; i < T; i += G * 512) rowsq[i] = 0.f;
        if (bx == 0) { unsigned* ctl = (unsigned*)(ws + WS_CTL); for (int i = tid; i < (int)(CTL_BYTES / 4); i += NWAVES * 64) ctl[i] = 0u; }
        LAS float* scr = (LAS float*)(lds + wave * 16384);
        constexpr int I_IN = 32 * (NINP / 32), I_MKV = 32 * 32;
        for (int it = gw; it < I_IN + I_MKV; it += NGW) {
            int r = it;
            if (r < I_IN) { transpose_item<true>(w_in, DM, NIN, Win_t, nullptr, scr, r, NINP / 32, lane); continue; } r -= I_IN;
            transpose_item<false>(w_mkv, DM, 1024, Wmkv_t, nullptr, scr, r, 32, lane);
        }
        for (int m = gw; m < T; m += NGW) rms_row_to_bf16(x + (size_t)m * DM, attn_g, XN + (size_t)m * DM, lane);
        for (int m = gw; m < TM; m += NGW) rms_row_to_bf16(mem + (size_t)m * DM, mem_g, MN + (size_t)m * DM, lane);
    }
    SEAM(0);
    xbar = xcd_barrier_post((unsigned*)(ws + WS_CTL), MISC);
    if (IN(1)) REPS(1) {
        pg8::OrderTwo S{XN, Win_t, MN, Wmkv_t, T / 256, NINP / 256, TM / 256, 1024 / 256, G, bx};
        pg8::EpiP1 E{PROJ, gates, MKV};
        pg8::gemm_phase<pg8::EpiP1, pg8::OrderTwo>(lds, DM, S, E);
        if (G == 256 && bx >= 192) late_weights(0, LW_EARLY, (bx - 192) * NWAVES + wave, 64 * NWAVES, w_out, w_up, w_dn, mlp_g, Wout_t, Wup_t, Wdn_t, (LAS float*)(lds + wave * 16384), lane);
    }
    SEAM(1);
    if (IN(2)) {
        unsigned* pcnt = (unsigned*)(ws + WS_CTL) + 4096;
        const int vcu0 = (G % 8 == 0) ? (bx % 8) * (G / 8) + bx / 8 : bx;
        for (int v = vcu0; v < 256; v += G) {
            const int j = v & 3, f = v >> 2;
            if (j >= 2) { const int item = f * 2 + (j - 2); gla::run(lds, item >> 3, item & 7, PROJ, gates, gla_w2, gla_ab, out_g, OG); }
            else {
                const int gw = (f * 2 + j) * NWAVES + wave; constexpr int NGW = 128 * NWAVES;
                if (wave == 0 && (f * 2 + j) < 64) {
                    const int bh = f * 2 + j; const float fb = fox_fb[bh & 3];
                    const float* gp = gates + ((size_t)(bh >> 2) * SEQ + lane * 32) * 32 + 16 + (bh & 3);
                    float zz[32]; float run_ = 0.f;
#pragma unroll
                    for (int i = 0; i < 32; ++i) zz[i] = gp[(size_t)i * 32];
#pragma unroll
                    for (int i = 0; i < 32; ++i) { zz[i] = logsig(zz[i] + fb); run_ += zz[i]; }
                    float pre = run_;
#pragma unroll
                    for (int o = 1; o < 64; o <<= 1) { const float t_ = __shfl_up(pre, o); if (lane >= o) pre += t_; }
                    float c = pre - run_;
                    float* np = negc + (size_t)bh * SEQ + lane * 32;
#pragma unroll
                    for (int i = 0; i < 32; i += 4) { f32x4 o4;
#pragma unroll
                        for (int e = 0; e < 4; ++e) { c += zz[i + e]; o4[e] = -c * 11.313708498984761f; }
                        *(f32x4*)(np + i) = o4; }
                }
                for (int m = gw; m < T; m += 4 * NGW) { bf16x8 vv[4][3];
#pragma unroll
                    for (int u = 0; u < 4; ++u) { const int mm = m + u * NGW; if (mm < T) { const bf16_t* p = PROJ + (size_t)mm * LDP; vv[u][0] = hn_load(p + C_FQ, lane); vv[u][1] = hn_load(p + C_FK, lane); vv[u][2] = hn_load(p + C_MQ, lane); } }
#pragma unroll
                    for (int u = 0; u < 4; ++u) { const int mm = m + u * NGW; if (mm < T) { bf16_t* p = PROJ + (size_t)mm * LDP; hn_finish(p + C_FQ, vv[u][0], fox_qg, lane); hn_finish(p + C_FK, vv[u][1], fox_kg, lane); hn_finish(p + C_MQ, vv[u][2], mem_qg, lane); } } }
                for (int m = gw; m < TM; m += 4 * NGW) { bf16x8 vv[4];
#pragma unroll
                    for (int u = 0; u < 4; ++u) { const int mm = m + u * NGW; if (mm < TM) vv[u] = hn_load(MKV + (size_t)mm * 1024, lane); }
#pragma unroll
                    for (int u = 0; u < 4; ++u) { const int mm = m + u * NGW; if (mm < TM) hn_finish(MKV + (size_t)mm * 1024, vv[u], mem_kg, lane); } }
                asm volatile("s_waitcnt vmcnt(0)" ::: "memory"); __syncthreads();
                if (tid == 0) { __builtin_amdgcn_fence(__ATOMIC_RELEASE, "agent"); asm volatile("s_waitcnt vmcnt(0)" ::: "memory"); (void)xb_add(pcnt, 1u); }
                late_weights(G == 256 ? LW_EARLY : 0, LW_TOTAL, gw, NGW, w_out, w_up, w_dn, mlp_g, Wout_t, Wup_t, Wdn_t, (LAS float*)(lds + wave * 16384), lane);
                __syncthreads();
            }
        }
        if (tid == 0) { unsigned sp = 0; while (xb_ld(pcnt) < 128u) { __builtin_amdgcn_s_sleep(2); if (++sp > (1u << 24)) break; }
            __builtin_amdgcn_fence(__ATOMIC_ACQUIRE, "agent"); asm volatile("s_waitcnt vmcnt(0)" ::: "memory"); }
        __syncthreads();
        const att::Ctx c{PROJ, MKV, OG, negc, out_g};
        unsigned* qh = (unsigned*)(ws + WS_CTL) + 4096 + 64;
        const int x0 = (int)(xb_xcc_id() & 7u);
#define GRAB() do { if (tid == 0) { int got = -1; for (int k_ = 0; k_ < 8 && got < 0; ++k_) { const int x_ = (x0 + k_) & 7; \
            const unsigned i_ = xb_add(qh + 64 * x_, 1u); if (i_ < 128u) got = att::queue_id(x_, (int)i_); } MISC[4] = (unsigned)got; } \
            __syncthreads(); } while (0)
        GRAB();
        int cur = __builtin_amdgcn_readfirstlane((int)MISC[4]);
        if (cur >= 0) {
            att::Seam S;
            att::prime(c, cur, (char*)lds_raw, S);
            for (;;) {
                GRAB();
                const int nx = __builtin_amdgcn_readfirstlane((int)MISC[4]); const int nxt = nx >= 0 ? nx : cur;
                if (att::is_fox(cur)) att::block<true>(c, cur, nxt, (char*)lds_raw, S); else att::block<false>(c, cur, nxt, (char*)lds_raw, S);
                if (nx < 0) break;
                cur = nxt;
            }
        }
#undef GRAB
    }
    SEAM(3);
    if (IN(4)) {
        pg8::OrderOne S{OG, Wout_t, T / 256, DM / 256, (T / 256) * (DM / 256), G, bx};
        pg8::EpiP4 E{x, out, HB, rowsq};
        pg8::gemm_phase<pg8::EpiP4, pg8::OrderOne>(lds, DM, S, E);
    }
    SEAM(4);
    if (IN(5)) REPS(5) {
        pg8::OrderOne S{HB, Wup_t, T / 256, DFF / 256, (T / 256) * (DFF / 256), G, bx};
        pg8::EpiP5 E{rowsq, UB};
        pg8::gemm_phase<pg8::EpiP5, pg8::OrderOne>(lds, DM, S, E);
    }
    SEAM(5);
    if (IN(6)) {
        pg8::OrderOne S{UB, Wdn_t, T / 256, DM / 256, (T / 256) * (DM / 256), G, bx};
        pg8::EpiP6 E{HB, out};
        pg8::gemm_phase<pg8::EpiP6, pg8::OrderOne>(lds, DFF, S, E);
    }
#undef IN
#undef SEAM
}

#ifndef MK_PER_PHASE
#define MK_PER_PHASE 0
#endif
extern "C" void kernel_launch(void* const* d_in, const int* in_sizes, int n_in, void* d_out, int out_size, void* d_ws, size_t ws_size, hipStream_t stream) {
    static int grid = 0;
    if (grid == 0) {
        if (n_in != 18 || in_sizes[0] != T * DM || out_size != T * DM || ws_size < WS_END) { fprintf(stderr, "kernel_launch: unexpected shapes (n_in %d, in0 %d, out %d, ws %zu)\n", n_in, n_in > 0 ? in_sizes[0] : -1, out_size, ws_size); grid = -1; return; }
        int dev = 0, cus = 0, per_cu = 0;
        if (hipGetDevice(&dev) != hipSuccess || hipDeviceGetAttribute(&cus, hipDeviceAttributeMultiprocessorCount, dev) != hipSuccess) { grid = -1; return; }
        if (hipFuncSetAttribute((const void*)hymba_fwd, hipFuncAttributeMaxDynamicSharedMemorySize, LDS_BYTES) != hipSuccess) { fprintf(stderr, "kernel_launch: hipFuncSetAttribute failed\n"); grid = -1; return; }
        if (hipOccupancyMaxActiveBlocksPerMultiprocessor(&per_cu, (const void*)hymba_fwd, NWAVES * 64, LDS_BYTES) != hipSuccess || per_cu < 1) { fprintf(stderr, "kernel_launch: occupancy query says %d\n", per_cu); per_cu = 1; }
        (void)hipGetLastError();
        grid = cus * per_cu;
    }
    if (grid < 0) return;
    Args a{};
    for (int i = 0; i < 18; ++i) a.in[i] = (const float*)d_in[i];
    a.out = (float*)d_out; a.ws = (unsigned char*)d_ws;
#if MK_PER_PHASE
    for (int p = 0; p < 7; ++p) { a.ph_lo = p; a.ph_hi = p + 1; hipLaunchKernelGGL(hymba_fwd, dim3(grid), dim3(NWAVES * 64), LDS_BYTES, stream, a); }
#else
    a.ph_lo = 0; a.ph_hi = 7;
    void* kargs[] = {&a};
    hipError_t e = hipLaunchCooperativeKernel((const void*)hymba_fwd, dim3(grid), dim3(NWAVES * 64), kargs, LDS_BYTES, stream);
    if (e != hipSuccess) fprintf(stderr, "kernel_launch: cooperative launch failed: %s (grid %d)\n", hipGetErrorString(e), grid);
#endif
}
```

```cpp
#include <hip/hip_runtime.h>
#include <hip/hip_cooperative_groups.h>
#include <cstdio>
#include <cstdint>
namespace cg = cooperative_groups;

#define LAS __attribute__((address_space(3)))
#define GAS __attribute__((address_space(1)))
typedef unsigned short bf16_t;
typedef short bf16x8 __attribute__((ext_vector_type(8)));
typedef short s16x4 __attribute__((ext_vector_type(4)));
typedef float f32x4 __attribute__((ext_vector_type(4)));
typedef float f32x16 __attribute__((ext_vector_type(16)));
typedef unsigned u32x4 __attribute__((ext_vector_type(4)));
typedef unsigned u32x2 __attribute__((ext_vector_type(2)));

constexpr int NB = 16, SEQ = 2048, DM = 2048, T = NB * SEQ, DFF = 8192, MEMT = 256, TM = NB * MEMT;
constexpr int NIN = 6164, NINP = 6400, LDP = 6144;
constexpr int C_GQ = 0, C_GK = 512, C_GV = 1024, C_GG = 2048, C_FQ = 3072, C_FK = 3584, C_FV = 4096, C_FG = 4608, C_MQ = 5120, C_MG = 5632;
constexpr float EPS = 1e-6f;
constexpr float LOG2E = 1.4426950408889634f;

constexpr size_t MiB = 1u << 20;
constexpr size_t WS_ROWSQ = 0;
constexpr size_t WS_NEGC = 1 * MiB;
constexpr size_t WS_GATES = 2 * MiB;
constexpr size_t WS_CTL = 7 * MiB, CTL_BYTES = 32768;
constexpr size_t WS_WIN = 8 * MiB;
constexpr size_t WS_WOUT = 34 * MiB;
constexpr size_t WS_WUP = 42 * MiB;
constexpr size_t WS_WDN = 74 * MiB;
constexpr size_t WS_WMKV = 106 * MiB;
constexpr size_t WS_MN = 110 * MiB;
constexpr size_t WS_MKV = 126 * MiB;
constexpr size_t WS_XN = 134 * MiB;
constexpr size_t WS_HB = 262 * MiB;
constexpr size_t WS_BIG = 390 * MiB;
constexpr size_t WS_END = 902 * MiB;

namespace pg8 {
constexpr int BM = 256, BK = 64, HALF = 128, HTB = HALF * BK * 2, STAGE_BYTES = 8 * HTB, NXCD = 8, WGM = 8;
__host__ __device__ __forceinline__ int lds_byte(int r, int c) { const int st = (r >> 4) * 2 + (c >> 5), rr = r & 15, cc = c & 31, ob = rr * 64 + cc * 2; return st * 1024 + (ob ^ (((ob >> 9) & 1) << 5)); }
__host__ __device__ __forceinline__ void stage_rc(int b, int& R, int& C) { const int st = b / 1024, sb = b % 1024, swz = sb ^ (((sb >> 9) & 1) << 5); R = (st >> 1) * 16 + swz / 64; C = (st & 1) * 32 + (swz % 64) / 2; }
__host__ __device__ __forceinline__ int perm32(int rho) { const int n = rho >> 4, i = rho & 15; return 8 * (i >> 2) + 4 * n + (i & 3); }

struct Unit { int pm, pn, g; };

__device__ __forceinline__ void tile_of(int wgid, int nM, int nN, int& pm, int& pn) {
    const int nwg = nM * nN;
    { const int q = nwg / NXCD, r = nwg % NXCD, xcd = wgid % NXCD, off = wgid / NXCD; wgid = (xcd < r ? xcd * (q + 1) : r * (q + 1) + (xcd - r) * q) + off; }
    const int nig = WGM * nN, gid = wgid / nig, fm = gid * WGM, gsz = (nM - fm) < WGM ? (nM - fm) : WGM;
    pm = fm + ((wgid % nig) % gsz); pn = (wgid % nig) / gsz;
}
struct OrderOne {
    const bf16_t* A; const bf16_t* Bt; int nM, nN, nwg, G, c;
    __device__ __forceinline__ bool next(int i, Unit& u) const { const long L = (long)i * G + c; if (L >= nwg) return false; tile_of((int)L, nM, nN, u.pm, u.pn); u.g = 0; return true; }
    __device__ __forceinline__ const char* abase(const Unit& u, size_t tstep) const { return (const char*)A + (size_t)u.pm * tstep; }
    __device__ __forceinline__ const char* bbase(const Unit& u, size_t tstep) const { return (const char*)Bt + (size_t)u.pn * tstep; }
};
struct OrderTwo {
    const bf16_t* A0; const bf16_t* B0; const bf16_t* A1; const bf16_t* B1; int nM0, nN0, nM1, nN1, G, c;
    __device__ __forceinline__ bool next(int i, Unit& u) const {
        long L = (long)i * G + c; const int n0 = nM0 * nN0;
        if (L < n0) { tile_of((int)L, nM0, nN0, u.pm, u.pn); u.g = 0; return true; }
        L -= n0; if (L >= nM1 * nN1) return false;
        u.pm = (int)L / nN1; u.pn = (int)L % nN1; u.g = 1; return true;
    }
    __device__ __forceinline__ const char* abase(const Unit& u, size_t tstep) const { return (const char*)(u.g ? A1 : A0) + (size_t)u.pm * tstep; }
    __device__ __forceinline__ const char* bbase(const Unit& u, size_t tstep) const { return (const char*)(u.g ? B1 : B0) + (size_t)u.pn * tstep; }
};

__device__ __forceinline__ unsigned cvt_pk_bf16(float lo, float hi) { unsigned r; asm volatile("v_cvt_pk_bf16_f32 %0, %1, %2" : "=v"(r) : "v"(lo), "v"(hi)); return r; }

template <class Epi, class Sched, bool ALIGN_EPI = true, bool SP2 = true>
__device__ __forceinline__ void gemm_phase(LAS unsigned char* lds, const int K, const Sched& S, const Epi& E) {
    const int tid = threadIdx.x, wid = __builtin_amdgcn_readfirstlane(tid >> 6), lane = tid & 63, wr = wid >> 2, wc = wid & 3, fr = lane & 15, fq = lane >> 4;
    const int nt = K / BK;
    unsigned voffA[2], voffB[2];
#pragma unroll
    for (int i = 0; i < 2; ++i) { int R, C; stage_rc(tid * 16 + i * 8192, R, C); const int Rb = Epi::PERM ? ((R & ~31) + perm32(R & 31)) : R;
        voffA[i] = (unsigned)(R * K + C) * 2u; voffB[i] = (unsigned)(Rb * K + C) * 2u; }
    const size_t kstep = (size_t)(BK * 2);
    const size_t hstep = (size_t)HALF * K * 2;
    const size_t tstep = 2 * hstep;
    const unsigned ldsw = (unsigned)wid * 1024u;
    const int aoff = lds_byte(wr * 64 + fr, fq * 8), boff = lds_byte(wc * 32 + fr, fq * 8);
#define PG8_SA(b, h) (((b) * 2 + (h)) * HTB)
#define PG8_SB(b, h) ((4 + (b) * 2 + (h)) * HTB)
#define PG8_STAGE(bufoff, gbase, voff) do { _Pragma("unroll") for (int _i = 0; _i < 2; ++_i) \
        __builtin_amdgcn_global_load_lds((const unsigned*)((const char*)(gbase) + (voff)[_i]), (LAS unsigned*)(lds + (bufoff) + ldsw + _i * 8192), 16, 0, 0); } while (0)
#define PG8_LDA(dst, b, h) do { _Pragma("unroll") for (int m = 0; m < 4; ++m) _Pragma("unroll") for (int k = 0; k < 2; ++k) dst[m][k] = *(const LAS bf16x8*)(lds + PG8_SA(b, h) + aoff + m * 2048 + k * 1024); } while (0)
#define PG8_LDB(dst, b, h) do { _Pragma("unroll") for (int n = 0; n < 2; ++n) _Pragma("unroll") for (int k = 0; k < 2; ++k) dst[n][k] = *(const LAS bf16x8*)(lds + PG8_SB(b, h) + boff + n * 2048 + k * 1024); } while (0)
#define PG8_MMA(ai, bj, At, Bt) do { __builtin_amdgcn_s_setprio(1); _Pragma("unroll") for (int m = 0; m < 4; ++m) _Pragma("unroll") for (int n = 0; n < 2; ++n) _Pragma("unroll") for (int k = 0; k < 2; ++k) \
        acc[ai][bj][m][n] = __builtin_amdgcn_mfma_f32_16x16x32_bf16(Bt[n][k], At[m][k], acc[ai][bj][m][n], 0, 0, 0); __builtin_amdgcn_s_setprio(0); } while (0)
#define PG8_WAIT_V(n) asm volatile("s_waitcnt vmcnt(" #n ")" ::: "memory")
#define PG8_WAIT_L(n) asm volatile("s_waitcnt lgkmcnt(" #n ")" ::: "memory")
#define PG8_BAR __builtin_amdgcn_s_barrier()
#define PG8_SCHED __builtin_amdgcn_sched_barrier(0)
    Unit cur, nxt; int ui = 0;
    if (!S.next(0, cur)) return;
    f32x4 acc[2][2][4][2];
#pragma unroll
    for (int a = 0; a < 2; ++a)
#pragma unroll
        for (int b = 0; b < 2; ++b)
#pragma unroll
            for (int m = 0; m < 4; ++m)
#pragma unroll
                for (int n = 0; n < 2; ++n) acc[a][b][m][n] = (f32x4){0.f, 0.f, 0.f, 0.f};
    bf16x8 At[4][2], B0[2][2], B1[2][2];
    const char* cA = S.abase(cur, tstep); const char* cB = S.bbase(cur, tstep);
    if constexpr (SP2) {
        PG8_STAGE(PG8_SB(0, 0), cB, voffB); PG8_STAGE(PG8_SB(0, 1), cB + hstep, voffB); PG8_STAGE(PG8_SA(0, 0), cA, voffA); PG8_STAGE(PG8_SA(0, 1), cA + hstep, voffA);
        if (wr == 1) PG8_BAR;
        PG8_WAIT_V(2); PG8_BAR;
        PG8_STAGE(PG8_SB(1, 0), cB + kstep, voffB); PG8_STAGE(PG8_SA(1, 0), cA + kstep, voffA); PG8_STAGE(PG8_SB(1, 1), cB + hstep + kstep, voffB);
        PG8_WAIT_V(6); PG8_BAR;
    } else {
        PG8_STAGE(PG8_SB(0, 0), cB, voffB); PG8_STAGE(PG8_SA(0, 0), cA, voffA); PG8_STAGE(PG8_SB(0, 1), cB + hstep, voffB); PG8_STAGE(PG8_SA(0, 1), cA + hstep, voffA);
        if (wr == 1) PG8_BAR;
        PG8_WAIT_V(4); PG8_BAR;
        PG8_STAGE(PG8_SB(1, 0), cB + kstep, voffB); PG8_STAGE(PG8_SA(1, 0), cA + kstep, voffA); PG8_STAGE(PG8_SB(1, 1), cB + hstep + kstep, voffB);
        PG8_WAIT_V(6); PG8_BAR;
    }
    for (;;) {
        const bool has_next = S.next(ui + 1, nxt);
        const char* nA = has_next ? S.abase(nxt, tstep) : cA; const char* nB = has_next ? S.bbase(nxt, tstep) : cB;
        for (int t = 0; t < nt; t += 2) {
            const bool last = (t == nt - 2);
            const char* a1 = cA + (size_t)(t + 1) * kstep;
            const char* a2 = last ? nA : cA + (size_t)(t + 2) * kstep; const char* b2 = last ? nB : cB + (size_t)(t + 2) * kstep;
            const char* a3 = a2 + kstep; const char* b3 = b2 + kstep;
            if constexpr (SP2) {
            PG8_LDB(B0, 0, 0); PG8_LDB(B1, 0, 1); PG8_SCHED; PG8_LDA(At, 0, 0); PG8_STAGE(PG8_SA(1, 1), a1 + hstep, voffA);
            PG8_WAIT_V(8); PG8_WAIT_L(0); PG8_BAR; PG8_MMA(0, 0, At, B0); PG8_MMA(0, 1, At, B1); PG8_BAR; PG8_SCHED;
            PG8_LDA(At, 0, 1); PG8_STAGE(PG8_SB(0, 0), b2, voffB); PG8_STAGE(PG8_SB(0, 1), b2 + hstep, voffB); PG8_STAGE(PG8_SA(0, 0), a2, voffA);
            PG8_WAIT_V(8); PG8_WAIT_L(0); PG8_BAR; PG8_MMA(1, 0, At, B0); PG8_MMA(1, 1, At, B1); PG8_BAR; PG8_SCHED;
            PG8_LDB(B0, 1, 0); PG8_LDB(B1, 1, 1); PG8_SCHED; PG8_LDA(At, 1, 0); PG8_STAGE(PG8_SA(0, 1), a2 + hstep, voffA);
            PG8_WAIT_V(8); PG8_WAIT_L(0); PG8_BAR; PG8_MMA(0, 0, At, B0); PG8_MMA(0, 1, At, B1); PG8_BAR; PG8_SCHED;
            PG8_LDA(At, 1, 1); PG8_STAGE(PG8_SB(1, 0), b3, voffB); PG8_STAGE(PG8_SB(1, 1), b3 + hstep, voffB); PG8_STAGE(PG8_SA(1, 0), a3, voffA);
            PG8_WAIT_V(8); PG8_WAIT_L(0); PG8_BAR; PG8_MMA(1, 0, At, B0); PG8_MMA(1, 1, At, B1); PG8_BAR; PG8_SCHED;
            } else {
            PG8_LDB(B0, 0, 0); PG8_SCHED; PG8_LDA(At, 0, 0); PG8_STAGE(PG8_SA(1, 1), a1 + hstep, voffA);
            PG8_WAIT_L(8); PG8_BAR; PG8_WAIT_L(0); PG8_MMA(0, 0, At, B0); PG8_BAR; PG8_SCHED;
            PG8_LDB(B1, 0, 1); PG8_STAGE(PG8_SB(0, 0), b2, voffB);
            PG8_BAR; PG8_WAIT_L(0); PG8_MMA(0, 1, At, B1); PG8_BAR;
            PG8_LDA(At, 0, 1); PG8_STAGE(PG8_SA(0, 0), a2, voffA);
            PG8_BAR; PG8_WAIT_L(0); PG8_MMA(1, 0, At, B0); PG8_BAR; PG8_SCHED;
            PG8_STAGE(PG8_SB(0, 1), b2 + hstep, voffB);
            PG8_WAIT_V(6); PG8_BAR; PG8_MMA(1, 1, At, B1); PG8_BAR;
            PG8_LDB(B0, 1, 0); PG8_SCHED; PG8_LDA(At, 1, 0); PG8_STAGE(PG8_SA(0, 1), a2 + hstep, voffA);
            PG8_WAIT_L(8); PG8_BAR; PG8_WAIT_L(0); PG8_MMA(0, 0, At, B0); PG8_BAR; PG8_SCHED;
            PG8_LDB(B1, 1, 1); PG8_STAGE(PG8_SB(1, 0), b3, voffB);
            PG8_BAR; PG8_WAIT_L(0); PG8_MMA(0, 1, At, B1); PG8_BAR;
            PG8_LDA(At, 1, 1); PG8_STAGE(PG8_SA(1, 0), a3, voffA);
            PG8_BAR; PG8_WAIT_L(0); PG8_MMA(1, 0, At, B0); PG8_BAR; PG8_SCHED;
            PG8_STAGE(PG8_SB(1, 1), b3 + hstep, voffB);
            PG8_WAIT_V(6); PG8_BAR; PG8_MMA(1, 1, At, B1); PG8_BAR;
            }
        }
        if constexpr (ALIGN_EPI) { if (wr == 0) PG8_BAR; }
        E(acc, cur, wr, wc, fr, fq);
        if (!has_next) break;
#pragma unroll
        for (int a = 0; a < 2; ++a)
#pragma unroll
            for (int b = 0; b < 2; ++b)
#pragma unroll
                for (int m = 0; m < 4; ++m)
#pragma unroll
                    for (int n = 0; n < 2; ++n) acc[a][b][m][n] = (f32x4){0.f, 0.f, 0.f, 0.f};
        cur = nxt; cA = nA; cB = nB; ++ui;
        if constexpr (ALIGN_EPI) { if (wr == 1) PG8_BAR; }
    }
    PG8_WAIT_V(0);
    if constexpr (!ALIGN_EPI) { if (wr == 0) PG8_BAR; }
    PG8_BAR;
#undef PG8_SA
#undef PG8_SB
#undef PG8_STAGE
#undef PG8_LDA
#undef PG8_LDB
#undef PG8_MMA
#undef PG8_WAIT_V
#undef PG8_WAIT_L
#undef PG8_BAR
#undef PG8_SCHED
}

__device__ __forceinline__ u32x4 pack8(f32x4 a, f32x4 b) { u32x4 w; w.x = cvt_pk_bf16(a[0], a[1]); w.y = cvt_pk_bf16(a[2], a[3]); w.z = cvt_pk_bf16(b[0], b[1]); w.w = cvt_pk_bf16(b[2], b[3]); return w; }

struct EpiP1 {
    static constexpr bool PERM = true;
    bf16_t* proj; float* gates; bf16_t* mkv;
    __device__ __forceinline__ void operator()(const f32x4 (&acc)[2][2][4][2], const Unit& u, int wr, int wc, int fr, int fq) const {
        const int row0 = u.pm * BM + wr * 64 + fr;
        if (u.g == 0 && u.pn == 24) {
            if (wc == 0) {
#pragma unroll
                for (int ai = 0; ai < 2; ++ai)
#pragma unroll
                    for (int m = 0; m < 4; ++m) { float* p = gates + (size_t)(row0 + ai * HALF + m * 16) * 32 + 8 * fq; *(f32x4*)p = acc[ai][0][m][0]; *(f32x4*)(p + 4) = acc[ai][0][m][1]; }
            }
            return;
        }
        bf16_t* base = u.g ? mkv : proj; const int ldc = u.g ? 1024 : LDP;
        const int col0 = u.pn * BM + wc * 32 + 8 * fq;
#pragma unroll
        for (int ai = 0; ai < 2; ++ai)
#pragma unroll
            for (int m = 0; m < 4; ++m) { bf16_t* rowp = base + (size_t)(row0 + ai * HALF + m * 16) * ldc + col0;
#pragma unroll
                for (int bj = 0; bj < 2; ++bj) *(u32x4*)(rowp + bj * HALF) = pack8(acc[ai][bj][m][0], acc[ai][bj][m][1]); }
    }
};
struct EpiP4 {
    static constexpr bool PERM = true;
    const float* x; float* out; bf16_t* hb; float* rowsq;
    __device__ __forceinline__ void operator()(const f32x4 (&acc)[2][2][4][2], const Unit& u, int wr, int wc, int fr, int fq) const {
        const int row0 = u.pm * BM + wr * 64 + fr; const int col0 = u.pn * BM + wc * 32 + 8 * fq;
#pragma unroll
        for (int ai = 0; ai < 2; ++ai)
#pragma unroll
            for (int m = 0; m < 4; ++m) { const int row = row0 + ai * HALF + m * 16; const size_t off = (size_t)row * DM + col0; float ss = 0.f;
#pragma unroll
                for (int bj = 0; bj < 2; ++bj) {
                    const f32x4 h0 = *(const f32x4*)(x + off + bj * HALF) + acc[ai][bj][m][0], h1 = *(const f32x4*)(x + off + bj * HALF + 4) + acc[ai][bj][m][1];
                    *(u32x4*)(hb + off + bj * HALF) = pack8(h0, h1);
                    ss += (h0[0] * h0[0] + h0[1] * h0[1]) + (h0[2] * h0[2] + h0[3] * h0[3]) + (h1[0] * h1[0] + h1[1] * h1[1]) + (h1[2] * h1[2] + h1[3] * h1[3]);
                }
                ss += __shfl_xor(ss, 16); ss += __shfl_xor(ss, 32);
                if (fq == 0) atomicAdd(rowsq + row, ss);
            }
    }
};
struct EpiP5 {
    static constexpr bool PERM = true;
    const float* rowsq; bf16_t* ub;
    __device__ __forceinline__ void operator()(const f32x4 (&acc)[2][2][4][2], const Unit& u, int wr, int wc, int fr, int fq) const {
        const int row0 = u.pm * BM + wr * 64 + fr; const int col0 = u.pn * BM + wc * 32 + 8 * fq;
        float rq[2][4];
#pragma unroll
        for (int ai = 0; ai < 2; ++ai)
#pragma unroll
            for (int m = 0; m < 4; ++m) rq[ai][m] = rowsq[row0 + ai * HALF + m * 16];
        __builtin_amdgcn_sched_barrier(0);
#pragma unroll
        for (int ai = 0; ai < 2; ++ai)
#pragma unroll
            for (int m = 0; m < 4; ++m) { const int row = row0 + ai * HALF + m * 16; const float r = __builtin_amdgcn_rsqf(rq[ai][m] * (1.0f / DM) + EPS);
                bf16_t* rowp = ub + (size_t)row * DFF + col0;
                const float r2 = r * r;
#pragma unroll
                for (int bj = 0; bj < 2; ++bj) { f32x4 a = acc[ai][bj][m][0], b = acc[ai][bj][m][1];
#pragma unroll
                    for (int e = 0; e < 4; ++e) { a[e] = fmaxf(a[e], 0.f); b[e] = fmaxf(b[e], 0.f); }
                    a = (a * a) * r2; b = (b * b) * r2;
                    *(u32x4*)(rowp + bj * HALF) = pack8(a, b); } }
    }
};
struct EpiP6 {
    static constexpr bool PERM = true;
    const bf16_t* hb; float* out;
    __device__ __forceinline__ void operator()(const f32x4 (&acc)[2][2][4][2], const Unit& u, int wr, int wc, int fr, int fq) const {
        const int row0 = u.pm * BM + wr * 64 + fr; const int col0 = u.pn * BM + wc * 32 + 8 * fq;
        u32x4 hv[2][4][2];
#pragma unroll
        for (int ai = 0; ai < 2; ++ai)
#pragma unroll
            for (int m = 0; m < 4; ++m) { const size_t off = (size_t)(row0 + ai * HALF + m * 16) * DM + col0; hv[ai][m][0] = *(const u32x4*)(hb + off); hv[ai][m][1] = *(const u32x4*)(hb + off + HALF); }
        __builtin_amdgcn_sched_barrier(0);
#pragma unroll
        for (int ai = 0; ai < 2; ++ai)
#pragma unroll
            for (int m = 0; m < 4; ++m) { const size_t off = (size_t)(row0 + ai * HALF + m * 16) * DM + col0;
#pragma unroll
                for (int bj = 0; bj < 2; ++bj) { const u32x4 w = hv[ai][m][bj];
                    f32x4 h0, h1;
                    h0[0] = __uint_as_float(w.x << 16); h0[1] = __uint_as_float(w.x & 0xffff0000u); h0[2] = __uint_as_float(w.y << 16); h0[3] = __uint_as_float(w.y & 0xffff0000u);
                    h1[0] = __uint_as_float(w.z << 16); h1[1] = __uint_as_float(w.z & 0xffff0000u); h1[2] = __uint_as_float(w.w << 16); h1[3] = __uint_as_float(w.w & 0xffff0000u);
                    *(f32x4*)(out + off + bj * HALF) = h0 + acc[ai][bj][m][0]; *(f32x4*)(out + off + bj * HALF + 4) = h1 + acc[ai][bj][m][1]; } }
    }
};
}

namespace att {
constexpr int D = 128, NW = 8, QBLK = 32, KVBLK = 64, QB = NW * QBLK;
constexpr int SHM_V = KVBLK * D * 2, SHM_K = KVBLK * D * 2;
constexpr int LDS_WS = 2 * SHM_V + 2 * SHM_K;
constexpr int LDS_NEGC = LDS_WS + NW * 64 * 4;
constexpr int LDS_STG = LDS_NEGC + 2048 * 4;
constexpr int SP = 132;
constexpr int LDS_BYTES = LDS_STG + NW * 16 * SP * 4;
constexpr float SCALE = 0.08838834764831845f;
constexpr float THR = 8.f;
#define KSWZ(row, colB) ((row) * 256 + ((colB) ^ (((row) & 7) << 4)))
#define SBAR() __builtin_amdgcn_sched_barrier(0)
__device__ __forceinline__ int v_st(int k, int c) { const int kk = (k & ~0xC) | ((k & 4) << 1) | ((k & 8) >> 1); return ((kk >> 3) * 4 + (c >> 5)) * 512 + ((kk & 7) * 32 + (c & 31)) * 2; }
__device__ __forceinline__ int v_rd_base(int lane) { return ((lane & 3) << 3) | (((lane >> 2) & 3) << 6) | (((lane >> 4) & 1) << 5) | (((lane >> 5) & 1) << 8); }
constexpr int v_rd_off(int d0, int ks, int half) { return d0 * 512 + ks * 4096 + half * 2048; }
__device__ __forceinline__ int crow(int r, int hi) { return (r & 3) + 8 * (r >> 2) + 4 * hi; }
__device__ __forceinline__ unsigned cvtpk(float lo, float hi) { unsigned r; asm volatile("v_cvt_pk_bf16_f32 %0, %1, %2" : "=v"(r) : "v"(lo), "v"(hi)); return r; }
__device__ __forceinline__ bf16x8 ld8(const bf16_t* p) { return *reinterpret_cast<const bf16x8*>(p); }
__device__ __forceinline__ float bf2f(unsigned short b) { return __uint_as_float((unsigned)b << 16); }

__device__ __forceinline__ void mask_tile(f32x16& p0, f32x16& p1, int dq) {
    const float NEG = -__builtin_inff();
#pragma unroll
    for (int r = 0; r < 16; ++r) {
        const int c = (r & 3) + 8 * (r >> 2);
        if (dq - c < 0) p0[r] = NEG;
        if (dq - c - 32 < 0) p1[r] = NEG;
    }
}
__device__ __forceinline__ void partialSM(f32x16& p0, f32x16& p1, float& m_reg, float& mn, float& alpha) {
    float pmax = p0[0];
#pragma unroll
    for (int r = 1; r < 16; ++r) pmax = fmaxf(pmax, p0[r]);
#pragma unroll
    for (int r = 0; r < 16; ++r) pmax = fmaxf(pmax, p1[r]);
    { auto rr = __builtin_amdgcn_permlane32_swap(__float_as_uint(pmax), __float_as_uint(pmax), false, false);
      pmax = fmaxf(__uint_as_float(rr[0]), __uint_as_float(rr[1])); }
    constexpr float C2 = 1.4426950408889634f * SCALE;
    if (__builtin_expect(__all((pmax - m_reg) * SCALE <= THR), 1)) { mn = m_reg; alpha = 1.f; }
    else { mn = fmaxf(m_reg, pmax); alpha = __builtin_amdgcn_exp2f((m_reg - mn) * C2); m_reg = mn; }
    const float mnL = -mn * C2;
#pragma unroll
    for (int r = 0; r < 16; ++r) p0[r] = fmaf(p0[r], C2, mnL);
#pragma unroll
    for (int r = 0; r < 16; ++r) p1[r] = fmaf(p1[r], C2, mnL);
#pragma unroll
    for (int r = 0; r < 16; ++r) p0[r] = __builtin_amdgcn_exp2f(p0[r]);
}
__device__ __forceinline__ void finishSM(f32x16& p0, f32x16& p1, float alpha, float& l_reg, bf16x8& pa0, bf16x8& pa1, bf16x8& pa2, bf16x8& pa3) {
#pragma unroll
    for (int r = 0; r < 16; ++r) p1[r] = __builtin_amdgcn_exp2f(p1[r]);
    float ps = 0;
#pragma unroll
    for (int r = 0; r < 16; ++r) ps += p0[r];
#pragma unroll
    for (int r = 0; r < 16; ++r) ps += p1[r];
    { auto rr = __builtin_amdgcn_permlane32_swap(__float_as_uint(ps), __float_as_uint(ps), false, false);
      ps = __uint_as_float(rr[0]) + __uint_as_float(rr[1]); }
    l_reg = l_reg * alpha + ps;
#define PK4(P, B_, OUT) do { unsigned a0 = cvtpk(P[B_+0], P[B_+1]), a1 = cvtpk(P[B_+2], P[B_+3]);                          \
        unsigned b0 = cvtpk(P[B_+4], P[B_+5]), b1 = cvtpk(P[B_+6], P[B_+7]);                                             \
        auto r0 = __builtin_amdgcn_permlane32_swap(a0, b0, false, false); auto r1 = __builtin_amdgcn_permlane32_swap(a1, b1, false, false); \
        u32x4 w = {r0[0], r1[0], r0[1], r1[1]}; OUT = *reinterpret_cast<bf16x8*>(&w); } while (0)
    PK4(p0, 0, pa0); PK4(p0, 8, pa1); PK4(p1, 0, pa2); PK4(p1, 8, pa3);
#undef PK4
}
template <int KB, bool BIAS>
__device__ __forceinline__ void qkt(f32x16& p0, f32x16& p1, const char* K_lds, int r32, int hi, const bf16x8* qr, const LAS float* nb) {
    if (BIAS) {
#pragma unroll
        for (int g = 0; g < 4; ++g) { const f32x4 a = *(const LAS f32x4*)(nb + 8 * g), b = *(const LAS f32x4*)(nb + 8 * g + 32);
            p0[4 * g] = a[0]; p0[4 * g + 1] = a[1]; p0[4 * g + 2] = a[2]; p0[4 * g + 3] = a[3];
            p1[4 * g] = b[0]; p1[4 * g + 1] = b[1]; p1[4 * g + 2] = b[2]; p1[4 * g + 3] = b[3]; }
    } else { p0 = f32x16{}; p1 = f32x16{}; }
    const char* kb[4];
#pragma unroll
    for (int dd = 0; dd < 4; ++dd) kb[dd] = K_lds + KB * SHM_K + KSWZ(r32, (dd * 16 + hi * 8) * 2);
#pragma unroll
    for (int d0 = 0; d0 < 8; ++d0) { const char* a = kb[d0 & 3] + (d0 >> 2) * 128;
        bf16x8 b0 = *reinterpret_cast<const bf16x8*>(a);
        bf16x8 b1 = *reinterpret_cast<const bf16x8*>(a + 32 * 256);
        p0 = __builtin_amdgcn_mfma_f32_32x32x16_bf16(b0, qr[d0], p0, 0, 0, 0);
        p1 = __builtin_amdgcn_mfma_f32_32x32x16_bf16(b1, qr[d0], p1, 0, 0, 0); }
}
template <int VB>
__device__ __forceinline__ void pv_tile(f32x16* o, int vb0, bf16x8 pa0, bf16x8 pa1, bf16x8 pa2, bf16x8 pa3) {
#define TRRD(dst, off) asm volatile("ds_read_b64_tr_b16 %0, %1 offset:%2" : "=&v"(dst) : "v"(vb0), "i"(off) : "memory")
#define PV_D0(d0) do { s16x4 l0, l1, l2, l3, h0, h1, h2, h3; constexpr int b_ = VB * SHM_V + v_rd_off(d0, 0, 0); \
        TRRD(l0, b_); TRRD(h0, b_ + 2048); TRRD(l1, b_ + 4096); TRRD(h1, b_ + 6144); TRRD(l2, b_ + 8192); TRRD(h2, b_ + 10240); TRRD(l3, b_ + 12288); TRRD(h3, b_ + 14336); \
        asm volatile("s_waitcnt lgkmcnt(0)" ::: "memory"); SBAR();   \
        o[d0] = __builtin_amdgcn_mfma_f32_32x32x16_bf16(pa0, (bf16x8){l0[0], l0[1], l0[2], l0[3], h0[0], h0[1], h0[2], h0[3]}, o[d0], 0, 0, 0);   \
        o[d0] = __builtin_amdgcn_mfma_f32_32x32x16_bf16(pa1, (bf16x8){l1[0], l1[1], l1[2], l1[3], h1[0], h1[1], h1[2], h1[3]}, o[d0], 0, 0, 0);   \
        o[d0] = __builtin_amdgcn_mfma_f32_32x32x16_bf16(pa2, (bf16x8){l2[0], l2[1], l2[2], l2[3], h2[0], h2[1], h2[2], h2[3]}, o[d0], 0, 0, 0);   \
        o[d0] = __builtin_amdgcn_mfma_f32_32x32x16_bf16(pa3, (bf16x8){l3[0], l3[1], l3[2], l3[3], h3[0], h3[1], h3[2], h3[3]}, o[d0], 0, 0, 0); } while (0)
    PV_D0(0); PV_D0(1); PV_D0(2); PV_D0(3);
#undef PV_D0
#undef TRRD
}

struct Ctx { const bf16_t* proj; const bf16_t* mkv; bf16_t* og; const float* negc; const float* outg; };
constexpr int NFOX = 64 * 8, NMEMB = 64 * 8;
__device__ __forceinline__ bool is_fox(int id) { return id < NFOX; }
__device__ __forceinline__ void dec(int id, int& b, int& h, int& qb) { const int m = id & (NFOX - 1), bh = m >> 3; qb = m & 7; b = bh >> 2; h = bh & 3; }
__device__ __forceinline__ int queue_id(int x, int i) { if (i < 64) return (8 * x + (i & 7)) * 8 + (7 - (i >> 3)); const int m = i - 64; return NFOX + (8 * x + (m >> 3)) * 8 + (m & 7); }
__device__ __forceinline__ int bin_len(int j) { return j == 3 ? 7 : 3; }
__device__ __forceinline__ int bin_id(int j, int f, int s) {
    if (s < 2) { const int qb = (j == 0) ? (s == 0 ? 7 : 4) : (j == 1) ? (s == 0 ? 6 : 5) : (j == 2) ? (s == 0 ? 3 : 2) : (s == 0 ? 1 : 0); return f * 8 + qb; }
    return NFOX + f * 8 + (j == 3 ? 3 + (s - 2) : j);
}
__device__ __forceinline__ void kv_of(const Ctx& c, int id, const char*& K, const char*& V, int& ldkv) {
    int b, h, qb; dec(id, b, h, qb);
    if (is_fox(id)) { const bf16_t* pb = c.proj + (size_t)b * SEQ * LDP; K = (const char*)(pb + C_FK + h * 128); V = (const char*)(pb + C_FV + h * 128); ldkv = LDP; }
    else { const bf16_t* kvb = c.mkv + (size_t)b * MEMT * 1024; K = (const char*)(kvb + h * 128); V = (const char*)(kvb + 512 + h * 128); ldkv = 1024; }
}
__device__ __forceinline__ const char* q_of(const Ctx& c, int id) {
    int b, h, qb; dec(id, b, h, qb);
    return (const char*)(c.proj + ((size_t)b * SEQ + (size_t)qb * 256) * LDP + (is_fox(id) ? C_FQ : C_MQ) + h * 128);
}
struct Seam { bf16x8 qr[8]; bf16x8 st_v0, st_v1, st_k0, st_k1; };
#define VMW() asm volatile("s_waitcnt vmcnt(0)" ::: "memory")
#define VMWN(n) asm volatile("s_waitcnt vmcnt(%0)" :: "i"(n) : "memory")
#define LD16(base, voff) (*reinterpret_cast<const bf16x8*>((base) + (voff)))
#define SLOAD_H(Kp, Vp, ld, o0, o1, k0) do { const size_t tb_ = (size_t)(k0) * (ld) * 2; S.st_v0 = LD16((Vp) + tb_, o0); S.st_v1 = LD16((Vp) + tb_, o1); S.st_k0 = LD16((Kp) + tb_, o0); S.st_k1 = LD16((Kp) + tb_, o1); } while (0)
#define SWRITE_HK(bf) do { *(bf16x8*)(K_lds + (bf) * SHM_K + kws) = S.st_k0; *(bf16x8*)(K_lds + (bf) * SHM_K + kws + 32 * 256) = S.st_k1; } while (0)
#define SWRITE_HV(bf) do { *(bf16x8*)(V_lds + (bf) * SHM_V + vst0) = S.st_v0; *(bf16x8*)(V_lds + (bf) * SHM_V + vst1) = S.st_v1; } while (0)
#define SWRITE_H(bf) do { SWRITE_HV(bf); SWRITE_HK(bf); } while (0)
__device__ __forceinline__ void load_q(Seam& S, const char* Qb, int wid, int r32, int hi) {
    const unsigned qo = (unsigned)(((wid * QBLK + r32) * LDP + hi * 8) * 2);
#pragma unroll
    for (int d0 = 0; d0 < 8; ++d0) S.qr[d0] = LD16(Qb, qo + d0 * 32);
}
__device__ __forceinline__ void prime(const Ctx& c, int id, char* lds, Seam& S) {
    const int tid = threadIdx.x, wid = __builtin_amdgcn_readfirstlane(tid >> 6), lane = tid & 63, r32 = lane & 31, hi = lane >> 5;
    const int sr = tid >> 4, sc = (tid & 15) * 8, kws = KSWZ(sr, sc * 2); char* K_lds = lds + 2 * SHM_V;
    load_q(S, q_of(c, id), wid, r32, hi);
    const char* Kh; const char* Vh; int ldkv; kv_of(c, id, Kh, Vh, ldkv);
    const unsigned o0 = (unsigned)((sr * ldkv + sc) * 2), o1 = o0 + (unsigned)(32 * ldkv * 2);
    SLOAD_H(Kh, Vh, ldkv, o0, o1, 0); VMW(); SWRITE_HK(0);
    __syncthreads();
}
template <bool FOX>
__device__ __forceinline__ void block(const Ctx& c, const int id, const int nid, char* lds, Seam& S) {
    int tid = threadIdx.x; asm volatile("" : "+v"(tid));
    const int wid = __builtin_amdgcn_readfirstlane(tid >> 6), lane = tid & 63, r32 = lane & 31, hi = lane >> 5;
    int cb, ch, cqb; dec(id, cb, ch, cqb);
    const int P0 = FOX ? cqb * 256 : 0;
    const int NT = FOX ? (P0 + QB) / KVBLK : MEMT / KVBLK;
    const int qlo = P0 + wid * QBLK, qm = qlo + r32 - 4 * hi;
    char* V_lds = lds; char* K_lds = lds + 2 * SHM_V;
    float* ws = (float*)(lds + LDS_WS) + wid * 64; float* li_l = ws, * al_l = ws + 32;
    const LAS float* negs = (const LAS float*)(uintptr_t)((unsigned)(uintptr_t)lds + LDS_NEGC) + 4 * hi;
    if (FOX) { const float* ng = c.negc + (size_t)(cb * 4 + ch) * SEQ; LAS float* nd = (LAS float*)(uintptr_t)((unsigned)(uintptr_t)lds + LDS_NEGC);
        const int n = P0 + QB; for (int i = tid * 4; i < n; i += 2048) *(LAS f32x4*)(nd + i) = *(const f32x4*)(ng + i); }
    if (FOX) __syncthreads();
    float m_reg = -1e30f, l_reg = 0; f32x16 o[4] = {};
    const int sr = tid >> 4, sc = (tid & 15) * 8, vst0 = v_st(sr, sc), vst1 = v_st(32 + sr, sc), kws = KSWZ(sr, sc * 2);
    const int vb0 = (int)(uintptr_t)V_lds + v_rd_base(lane);
    const char* Kh; const char* Vh; int ldkv; kv_of(c, id, Kh, Vh, ldkv);
    const unsigned o0 = (unsigned)((sr * ldkv + sc) * 2), o1 = o0 + (unsigned)(32 * ldkv * 2);
#define RESC(a) do { if (__any((a) < 1.f)) { if (hi == 0) al_l[r32] = (a); asm volatile("s_waitcnt lgkmcnt(0)" ::: "memory");              \
                     for (int d_ = 0; d_ < 4; ++d_) for (int r = 0; r < 16; ++r) o[d_][r] *= al_l[crow(r, hi)]; } } while (0)
#define KBASE(t) ((t) * KVBLK)
#define MASKT(P0_, P1_, t) do { if (FOX) { const int kb_ = KBASE(t); if (kb_ + KVBLK - 1 > qlo) mask_tile(P0_, P1_, qm - kb_); } } while (0)
#define SEAM_K0() do { VMWN(8); SWRITE_HK(0); SBAR(); } while (0)
    f32x16 pA0, pA1, pB0, pB1; float mnA, mnB, alA, alB; bf16x8 pa0, pa1, pa2, pa3;
    SWRITE_HV(0); SBAR();
    if (NT > 1) { SLOAD_H(Kh, Vh, ldkv, o0, o1, KBASE(1)); }
    SBAR(); qkt<0, FOX>(pA0, pA1, K_lds, r32, hi, S.qr, negs + KBASE(0));
    MASKT(pA0, pA1, 0); partialSM(pA0, pA1, m_reg, mnA, alA);
    if (NT > 1) { VMW(); SWRITE_H(1); }
    __syncthreads();
#define HALF_STEP(PX0, PX1, mnX, alX, PY0, PY1, alY, t, KB, VB, SB) do {                                                      \
        SBAR(); qkt<KB, FOX>(PX0, PX1, K_lds, r32, hi, S.qr, negs + KBASE(t));                                                \
        finishSM(PY0, PY1, alY, l_reg, pa0, pa1, pa2, pa3); SBAR();                                                           \
        if ((t) + 1 < NT) { SLOAD_H(Kh, Vh, ldkv, o0, o1, KBASE((t) + 1)); SBAR(); }                                          \
        pv_tile<VB>(o, vb0, pa0, pa1, pa2, pa3); MASKT(PX0, PX1, (t)); partialSM(PX0, PX1, m_reg, mnX, alX);                  \
        __syncthreads();                                                                                                      \
        if ((t) + 1 < NT) { VMW(); SWRITE_H(SB); }                                                                            \
        RESC(alX); __syncthreads(); } while (0)
    for (int t = 1; t + 1 < NT; t += 2) {
        HALF_STEP(pB0, pB1, mnB, alB, pA0, pA1, alA, t, 1, 0, 0);
        HALF_STEP(pA0, pA1, mnA, alA, pB0, pB1, alB, t + 1, 0, 1, 1);
    }
    SBAR(); qkt<1, FOX>(pB0, pB1, K_lds, r32, hi, S.qr, negs + KBASE(NT - 1)); SBAR();
    { const char* nK; const char* nV; int nld; kv_of(c, nid, nK, nV, nld);
      const unsigned n0 = (unsigned)((sr * nld + sc) * 2), n1 = n0 + (unsigned)(32 * nld * 2);
      SLOAD_H(nK, nV, nld, n0, n1, 0); SBAR();
      load_q(S, q_of(c, nid), wid, r32, hi); }
    SBAR();
    finishSM(pA0, pA1, alA, l_reg, pa0, pa1, pa2, pa3); SBAR();
    pv_tile<0>(o, vb0, pa0, pa1, pa2, pa3);
    MASKT(pB0, pB1, NT - 1); partialSM(pB0, pB1, m_reg, mnB, alB); __syncthreads(); RESC(alB);
    finishSM(pB0, pB1, alB, l_reg, pa0, pa1, pa2, pa3); SBAR(); pv_tile<1>(o, vb0, pa0, pa1, pa2, pa3);
    SBAR(); SEAM_K0();
    if (hi == 0) li_l[r32] = l_reg; asm volatile("s_waitcnt lgkmcnt(0)" ::: "memory");
    {
        const int head = (FOX ? 8 : 12) + ch;
        LAS float* stg = (LAS float*)(uintptr_t)((unsigned)(uintptr_t)lds + LDS_STG) + wid * (16 * SP);
        const int erow = lane >> 2, eq = lane & 3;
        unsigned eo = (unsigned)(erow * LDP + eq * 32), eo2 = (unsigned)(erow * DM + eq * 32);
        asm volatile("" : "+v"(eo), "+v"(eo2));
        const size_t row0 = (size_t)cb * SEQ + (size_t)cqb * 256 + wid * QBLK;
        const bf16_t* gbase = c.proj + row0 * LDP + (FOX ? C_FG : C_MG) + ch * 128;
        bf16_t* obase = c.og + row0 * DM + head * 128;
        const float* gnp = c.outg + head * 128 + eq * 32;
#pragma unroll
        for (int rd = 0; rd < 2; ++rd) {
#pragma unroll
            for (int rr = 0; rr < 8; ++rr) { const int r = rd * 8 + rr; const int lrow = (rr & 3) + 8 * (rr >> 2) + 4 * hi;
                const float rl = __builtin_amdgcn_rcpf(li_l[crow(r, hi)]);
#pragma unroll
                for (int d0 = 0; d0 < 4; ++d0) stg[lrow * SP + d0 * 32 + r32] = o[d0][r] * rl; }
            bf16x8 g[4];
#pragma unroll
            for (int q = 0; q < 4; ++q) g[q] = *(const bf16x8*)(gbase + (size_t)rd * 16 * LDP + eo + 8 * q);
            asm volatile("s_waitcnt lgkmcnt(0)" ::: "memory");
            f32x4 v[8]; float ss = 0.f;
#pragma unroll
            for (int q = 0; q < 8; ++q) { v[q] = *(const LAS f32x4*)(stg + erow * SP + eq * 32 + 4 * q); ss += (v[q][0] * v[q][0] + v[q][1] * v[q][1]) + (v[q][2] * v[q][2] + v[q][3] * v[q][3]); }
            ss += __shfl_xor(ss, 1); ss += __shfl_xor(ss, 2);
            const float rn = __builtin_amdgcn_rsqf(ss * (1.0f / 128.0f) + EPS);
            unsigned w[16];
#pragma unroll
            for (int q = 0; q < 8; ++q) { const f32x4 gq = *(const f32x4*)(gnp + 4 * q); float val[4];
#pragma unroll
                for (int e = 0; e < 4; ++e) { const float gt = bf2f((unsigned short)g[q >> 1][(q & 1) * 4 + e]); val[e] = v[q][e] * rn * gq[e] * __builtin_amdgcn_rcpf(1.0f + __expf(-gt)); }
                w[2 * q] = cvtpk(val[0], val[1]); w[2 * q + 1] = cvtpk(val[2], val[3]); }
            bf16_t* op = obase + (size_t)rd * 16 * DM + eo2;
#pragma unroll
            for (int q = 0; q < 4; ++q) *(u32x4*)(op + 8 * q) = (u32x4){w[4 * q], w[4 * q + 1], w[4 * q + 2], w[4 * q + 3]};
            asm volatile("s_waitcnt lgkmcnt(0)" ::: "memory");
        }
    }
    __syncthreads();
#undef RESC
#undef KBASE
#undef MASKT
#undef SEAM_K0
#undef HALF_STEP
}
#undef VMW
#undef VMWN
#undef LD16
#undef SLOAD_H
#undef SWRITE_HK
#undef SWRITE_HV
#undef SWRITE_H
}

namespace gla {
constexpr int LS = 72;
constexpr int O_W2 = 0, O_AB = 4096, O_GAIN = 4352, O_BL = 4864, O_QS = 5120, O_KS = 14336, O_KDT = 23552, O_VT = 32768, O_P = 51200, O_ST0 = 60416, O_ST1 = 78848, O_OUT = 97280, LDS_BYTES = 131072;
constexpr int OP = 132;
__device__ __forceinline__ int crow(int r, int hi) { return (r & 3) + 8 * (r >> 2) + 4 * hi; }
__device__ __forceinline__ unsigned short f2bf(float f) { unsigned u = __float_as_uint(f); return (unsigned short)((u + 0x7fffu + ((u >> 16) & 1u)) >> 16); }
__device__ __forceinline__ float bf2f(unsigned short b) { return __uint_as_float((unsigned)b << 16); }
typedef float f32x2_t __attribute__((ext_vector_type(2))); typedef __bf16 bf16x2_t __attribute__((ext_vector_type(2)));
__device__ __forceinline__ unsigned cvtpk(float lo, float hi) { f32x2_t v = {lo, hi}; bf16x2_t b = __builtin_convertvector(v, bf16x2_t); return __builtin_bit_cast(unsigned, b); }
__device__ __forceinline__ bf16x8 frag(const LAS unsigned char* base, int row, int kk) { return *(const LAS bf16x8*)(base + row * (LS * 2) + kk * 2); }
__device__ __forceinline__ unsigned short bf1(float f) { return (unsigned short)cvtpk(f, 0.f); }
template <int CTRL> __device__ __forceinline__ float dpp0(float v) { return __builtin_bit_cast(float, __builtin_amdgcn_update_dpp(0, __builtin_bit_cast(int, v), CTRL, 0xf, 0xf, false)); }
__device__ __forceinline__ float wave_scan(float v, int lane) {
    v += dpp0<0x111>(v); v += dpp0<0x112>(v); v += dpp0<0x114>(v); v += dpp0<0x118>(v);
    const float s15 = __builtin_bit_cast(float, __builtin_amdgcn_readlane(__builtin_bit_cast(int, v), 15));
    const float s31 = __builtin_bit_cast(float, __builtin_amdgcn_readlane(__builtin_bit_cast(int, v), 31));
    const float s47 = __builtin_bit_cast(float, __builtin_amdgcn_readlane(__builtin_bit_cast(int, v), 47));
    return v + ((lane >= 16 ? s15 : 0.f) + (lane >= 32 ? s31 : 0.f) + (lane >= 48 ? s47 : 0.f));
}

__device__ __forceinline__ void run(LAS unsigned char* lds, int b, int h, const bf16_t* proj, const float* gates, const float* w2, const float* ab, const float* ong, bf16_t* og) {
    const int tid = threadIdx.x, wid = __builtin_amdgcn_readfirstlane(tid >> 6), lane = tid & 63, r32 = lane & 31, hi = lane >> 5;
    LAS float* w2_s = (LAS float*)(lds + O_W2); LAS float* ab_s = (LAS float*)(lds + O_AB); LAS float* gain_s = (LAS float*)(lds + O_GAIN); LAS float* bl_s = (LAS float*)(lds + O_BL);
    LAS float* out_s = (LAS float*)(lds + O_OUT);
    for (int i = tid; i < 1024; i += 512) w2_s[i] = w2[(i >> 6) * 512 + h * 64 + (i & 63)];
    if (tid < 64) ab_s[tid] = ab[h * 64 + tid];
    if (tid < 128) gain_s[tid] = ong[h * 128 + tid];
    for (int i = tid * 16; i < 128 * LS * 2; i += 512 * 16) *(LAS u32x4*)(lds + O_ST0 + i) = (u32x4){0u, 0u, 0u, 0u};
    const int ib = wid >> 2, db = wid & 3;
    const int dvb = wid >> 1, dkb = wid & 1;
    f32x16 accS = {};
    const int erow = tid >> 3, ecg = tid & 7;
    const size_t rowb = (size_t)b * SEQ;
    const bf16_t* pl = proj + (rowb + lane) * LDP;
    const float* gl = gates + (rowb + lane) * 32;
    const bf16_t* pg = proj + (rowb + erow) * LDP + C_GG + h * 128 + ecg * 16;
    bf16x8 qv = *(const bf16x8*)(pl + C_GQ + h * 64 + 8 * wid), kv = *(const bf16x8*)(pl + C_GK + h * 64 + 8 * wid);
    bf16x8 v0 = *(const bf16x8*)(pl + C_GV + h * 128 + 16 * wid), v1 = *(const bf16x8*)(pl + C_GV + h * 128 + 16 * wid + 8);
    f32x4 ga0 = *(const f32x4*)(gl), ga1 = *(const f32x4*)(gl + 4), ga2 = *(const f32x4*)(gl + 8), ga3 = *(const f32x4*)(gl + 12);
    bf16x8 gt0 = *(const bf16x8*)(pg), gt1 = *(const bf16x8*)(pg + 8);
    __syncthreads();
    for (int n = 0; n < SEQ / 64; ++n) {
        const size_t r0 = rowb + (size_t)n * 64;
        {
            float z[8];
            { const f32x4 a0 = *(const LAS f32x4*)(ab_s + 8 * wid), a1 = *(const LAS f32x4*)(ab_s + 8 * wid + 4);
              z[0] = a0[0]; z[1] = a0[1]; z[2] = a0[2]; z[3] = a0[3]; z[4] = a1[0]; z[5] = a1[1]; z[6] = a1[2]; z[7] = a1[3]; }
            const float gaf[16] = {ga0[0], ga0[1], ga0[2], ga0[3], ga1[0], ga1[1], ga1[2], ga1[3], ga2[0], ga2[1], ga2[2], ga2[3], ga3[0], ga3[1], ga3[2], ga3[3]};
#pragma unroll
            for (int r = 0; r < 16; ++r) { const f32x4 w0 = *(const LAS f32x4*)(w2_s + r * 64 + 8 * wid), w1 = *(const LAS f32x4*)(w2_s + r * 64 + 8 * wid + 4);
                z[0] = fmaf(gaf[r], w0[0], z[0]); z[1] = fmaf(gaf[r], w0[1], z[1]); z[2] = fmaf(gaf[r], w0[2], z[2]); z[3] = fmaf(gaf[r], w0[3], z[3]);
                z[4] = fmaf(gaf[r], w1[0], z[4]); z[5] = fmaf(gaf[r], w1[1], z[5]); z[6] = fmaf(gaf[r], w1[2], z[6]); z[7] = fmaf(gaf[r], w1[3], z[7]); }
            float b2[8];
#pragma unroll
            for (int j = 0; j < 8; ++j) b2[j] = (fminf(z[j], 0.f) - __logf(1.0f + __expf(-fabsf(z[j])))) * (LOG2E / 16.0f);
#pragma unroll
            for (int j = 0; j < 8; ++j) b2[j] = wave_scan(b2[j], lane);
            float qf[8], kf[8];
#pragma unroll
            for (int j = 0; j < 8; ++j) { const float bl = __builtin_bit_cast(float, __builtin_amdgcn_readlane(__builtin_bit_cast(int, b2[j]), 63)); if (lane == 63) bl_s[8 * wid + j] = bl;
                const float q = bf2f((unsigned short)qv[j]), k = bf2f((unsigned short)kv[j]);
                qf[j] = q * 0.125f * __builtin_amdgcn_exp2f(b2[j]); kf[j] = k * __builtin_amdgcn_exp2f(-b2[j]);
                *(LAS unsigned short*)(lds + O_KDT + (8 * wid + j) * (LS * 2) + lane * 2) = bf1(k * __builtin_amdgcn_exp2f(bl - b2[j]));
                *(LAS unsigned short*)(lds + O_VT + (16 * wid + j) * (LS * 2) + lane * 2) = (unsigned short)v0[j];
                *(LAS unsigned short*)(lds + O_VT + (16 * wid + 8 + j) * (LS * 2) + lane * 2) = (unsigned short)v1[j]; }
            *(LAS u32x4*)(lds + O_QS + lane * (LS * 2) + 16 * wid) = (u32x4){cvtpk(qf[0], qf[1]), cvtpk(qf[2], qf[3]), cvtpk(qf[4], qf[5]), cvtpk(qf[6], qf[7])};
            *(LAS u32x4*)(lds + O_KS + lane * (LS * 2) + 16 * wid) = (u32x4){cvtpk(kf[0], kf[1]), cvtpk(kf[2], kf[3]), cvtpk(kf[4], kf[5]), cvtpk(kf[6], kf[7])};
        }
        if (n + 1 < SEQ / 64) { const bf16_t* pn = pl + (size_t)(n + 1) * 64 * LDP; const float* gn = gl + (size_t)(n + 1) * 64 * 32;
            qv = *(const bf16x8*)(pn + C_GQ + h * 64 + 8 * wid); kv = *(const bf16x8*)(pn + C_GK + h * 64 + 8 * wid);
            v0 = *(const bf16x8*)(pn + C_GV + h * 128 + 16 * wid); v1 = *(const bf16x8*)(pn + C_GV + h * 128 + 16 * wid + 8);
            ga0 = *(const f32x4*)(gn); ga1 = *(const f32x4*)(gn + 4); ga2 = *(const f32x4*)(gn + 8); ga3 = *(const f32x4*)(gn + 12); }
        asm volatile("s_waitcnt lgkmcnt(0)" ::: "memory"); __builtin_amdgcn_s_barrier(); asm volatile("" ::: "memory");
        const LAS unsigned char* STc = lds + ((n & 1) ? O_ST1 : O_ST0); LAS unsigned char* STn = lds + ((n & 1) ? O_ST0 : O_ST1);
        f32x16 acc = {};
        if (wid < 3) { const int sib = wid > 0, sjb = wid > 1; f32x16 sc = {};
#pragma unroll
            for (int s = 0; s < 4; ++s) sc = __builtin_amdgcn_mfma_f32_32x32x16_bf16(frag(lds + O_QS, sib * 32 + r32, s * 16 + hi * 8), frag(lds + O_KS, sjb * 32 + r32, s * 16 + hi * 8), sc, 0, 0, 0);
#pragma unroll
            for (int r = 0; r < 16; ++r) { const int i = sib * 32 + crow(r, hi), j = sjb * 32 + r32; *(LAS unsigned short*)(lds + O_P + i * (LS * 2) + j * 2) = bf1(i >= j ? sc[r] : 0.f); } }
#pragma unroll
        for (int s = 0; s < 4; ++s) acc = __builtin_amdgcn_mfma_f32_32x32x16_bf16(frag(lds + O_QS, ib * 32 + r32, s * 16 + hi * 8), frag(STc, db * 32 + r32, s * 16 + hi * 8), acc, 0, 0, 0);
        { const float dec = __builtin_amdgcn_exp2f(bl_s[dkb * 32 + r32]);
#pragma unroll
          for (int r = 0; r < 16; ++r) accS[r] *= dec;
#pragma unroll
          for (int s = 0; s < 4; ++s) accS = __builtin_amdgcn_mfma_f32_32x32x16_bf16(frag(lds + O_VT, dvb * 32 + r32, s * 16 + hi * 8), frag(lds + O_KDT, dkb * 32 + r32, s * 16 + hi * 8), accS, 0, 0, 0);
#pragma unroll
          for (int r = 0; r < 16; ++r) *(LAS unsigned short*)(STn + (dvb * 32 + crow(r, hi)) * (LS * 2) + (dkb * 32 + r32) * 2) = bf1(accS[r]); }
        asm volatile("s_waitcnt lgkmcnt(0)" ::: "memory"); __builtin_amdgcn_s_barrier(); asm volatile("" ::: "memory");
#pragma unroll
        for (int s = 0; s < 4; ++s) if (ib == 1 || s < 2) acc = __builtin_amdgcn_mfma_f32_32x32x16_bf16(frag(lds + O_P, ib * 32 + r32, s * 16 + hi * 8), frag(lds + O_VT, db * 32 + r32, s * 16 + hi * 8), acc, 0, 0, 0);
#pragma unroll
        for (int r = 0; r < 16; ++r) out_s[(ib * 32 + crow(r, hi)) * OP + db * 32 + r32] = acc[r];
        asm volatile("s_waitcnt lgkmcnt(0)" ::: "memory"); __builtin_amdgcn_s_barrier(); asm volatile("" ::: "memory");
        {
            f32x4 o4[4]; float ss = 0.f;
#pragma unroll
            for (int q = 0; q < 4; ++q) { o4[q] = *(const LAS f32x4*)(out_s + erow * OP + ecg * 16 + 4 * q); ss += (o4[q][0] * o4[q][0] + o4[q][1] * o4[q][1]) + (o4[q][2] * o4[q][2] + o4[q][3] * o4[q][3]); }
            ss += __shfl_xor(ss, 1); ss += __shfl_xor(ss, 2); ss += __shfl_xor(ss, 4);
            const float rn = __builtin_amdgcn_rsqf(ss * (1.0f / 128.0f) + EPS);
            unsigned w[8];
#pragma unroll
            for (int q = 0; q < 4; ++q) { const f32x4 gq = *(const LAS f32x4*)(gain_s + ecg * 16 + 4 * q); float val[4];
#pragma unroll
                for (int e = 0; e < 4; ++e) { const int c = 4 * q + e; const float gt = bf2f((unsigned short)(c < 8 ? gt0[c & 7] : gt1[c & 7]));
                    val[e] = o4[q][e] * rn * gq[e] * gt * __builtin_amdgcn_rcpf(1.0f + __expf(-gt)); }
                w[2 * q] = cvtpk(val[0], val[1]); w[2 * q + 1] = cvtpk(val[2], val[3]); }
            bf16_t* op = og + (r0 + erow) * DM + h * 128 + ecg * 16;
            *(u32x4*)op = (u32x4){w[0], w[1], w[2], w[3]}; *(u32x4*)(op + 8) = (u32x4){w[4], w[5], w[6], w[7]};
            if (n + 1 < SEQ / 64) { const bf16_t* pgn = pg + (size_t)(n + 1) * 64 * LDP; gt0 = *(const bf16x8*)(pgn); gt1 = *(const bf16x8*)(pgn + 8); }
        }
    }
    __syncthreads();
}
}


#define XB_TMO      128
#define XB_XCNT(j)  (256  + 64 * (j))
#define XB_XSUB(j)  (1280 + 64 * (j))
#define XB_XGEN(j)  (2304 + 64 * (j))
#define XB_TOP      3328
#define XB_TOPGEN   3392
#define XCD_BAR_WORDS 3456
#define XB_SPIN_CAP (1u << 18)
__device__ __forceinline__ unsigned xb_ld(unsigned* p)              { return __hip_atomic_load(p, __ATOMIC_RELAXED, __HIP_MEMORY_SCOPE_AGENT); }
__device__ __forceinline__ unsigned xb_add(unsigned* p, unsigned v) { return __hip_atomic_fetch_add(p, v, __ATOMIC_RELAXED, __HIP_MEMORY_SCOPE_AGENT); }
__device__ __forceinline__ unsigned xb_xcc_id() { return (unsigned)__builtin_amdgcn_s_getreg((3 << 11) | 20) & 0xFu; }
#define XB_SPIN(cond, bar) do { unsigned _sp = 0; while (cond) { __builtin_amdgcn_s_sleep(1); \
    if ((++_sp & 255u) == 0u) { if (xb_ld(&(bar)[XB_TMO])) break; if (_sp > XB_SPIN_CAP) { atomicAdd(&(bar)[XB_TMO], 1u); break; } } } } while (0)
struct XcdBarrier { unsigned* bar; unsigned x; volatile LAS unsigned* st; };
__device__ __forceinline__ XcdBarrier xcd_barrier_post(unsigned* bar, volatile LAS unsigned* st) {
    XcdBarrier b; b.bar = bar; b.x = xb_xcc_id(); b.st = st;
    if (threadIdx.x == 0) (void)xb_add(&bar[XB_XCNT(b.x)], 1u);
    return b;
}
__device__ __forceinline__ void xcd_barrier_complete(unsigned* bar, unsigned x, unsigned& nloc, unsigned& nx) {
    const unsigned G = gridDim.x * gridDim.y * gridDim.z;
    unsigned sum, cnt, mine, sp = 0u;
    for (;;) {
        sum = 0u; cnt = 0u; mine = 0u;
#pragma unroll
        for (unsigned j = 0; j < 16; ++j) { const unsigned c = xb_ld(&bar[XB_XCNT(j)]); sum += c; cnt += (c > 0u) ? 1u : 0u; mine = (j == x) ? c : mine; }
        if (sum == G) break;
        __builtin_amdgcn_s_sleep(1);
        if ((++sp & 255u) == 0u) { if (xb_ld(&bar[XB_TMO])) break; if (sp > XB_SPIN_CAP) { atomicAdd(&bar[XB_TMO], 1u); break; } }
    }
    nloc = mine > 0u ? mine : 1u; nx = cnt > 0u ? cnt : 1u;
}
__device__ __forceinline__ void xcd_barrier(const XcdBarrier& b) {
    asm volatile("s_waitcnt vmcnt(0)" ::: "memory");
    __syncthreads();
    if (threadIdx.x == 0) {
        unsigned* bar = b.bar;
        __builtin_amdgcn_s_waitcnt(0);
        unsigned nloc = b.st[0], nx = b.st[1];
        if (nloc == 0u) { xcd_barrier_complete(bar, b.x, nloc, nx); b.st[0] = nloc; b.st[1] = nx; }
        const unsigned old = xb_add(&bar[XB_XSUB(b.x)], 1u);
        const unsigned gen = old / nloc;
        if (old + 1u == (gen + 1u) * nloc) {
            __builtin_amdgcn_fence(__ATOMIC_RELEASE, "agent");
            asm volatile("s_waitcnt vmcnt(0)" ::: "memory");
            const unsigned og = xb_add(&bar[XB_TOP], 1u);
            const unsigned tg = og / nx;
            if (og + 1u == (tg + 1u) * nx) xb_add(&bar[XB_TOPGEN], 1u);
            else XB_SPIN(xb_ld(&bar[XB_TOPGEN]) == tg, bar);
            __builtin_amdgcn_fence(__ATOMIC_ACQUIRE, "agent");
            xb_add(&bar[XB_XGEN(b.x)], 1u);
            asm volatile("s_waitcnt vmcnt(0)" ::: "memory");
        } else {
            XB_SPIN(xb_ld(&bar[XB_XGEN(b.x)]) == gen, bar);
            __builtin_amdgcn_fence(__ATOMIC_ACQUIRE, "agent");
            asm volatile("s_waitcnt vmcnt(0)" ::: "memory");
        }
    }
    __syncthreads();
}

constexpr int NWAVES = 8;
constexpr int LDS_BYTES = 147456;
constexpr int MISC_OFF = 143360;
static_assert(pg8::STAGE_BYTES <= MISC_OFF && att::LDS_BYTES <= MISC_OFF && gla::LDS_BYTES <= MISC_OFF && MISC_OFF + 256 <= LDS_BYTES, "LDS map");

struct Args { const float* in[18]; float* out; unsigned char* ws; int ph_lo, ph_hi; };

__device__ __forceinline__ unsigned short f2bf(float f) { unsigned u = __float_as_uint(f); return (unsigned short)((u + 0x7fffu + ((u >> 16) & 1u)) >> 16); }
__device__ __forceinline__ unsigned pk2(float lo, float hi) { return (unsigned)f2bf(lo) | ((unsigned)f2bf(hi) << 16); }
__device__ __forceinline__ float wave_sum(float v) {
#pragma unroll
    for (int o = 1; o < 64; o <<= 1) v += __shfl_xor(v, o);
    return v;
}
__device__ __forceinline__ int win_src(int n) {
    if (n < 3072) return n;
    if (n < 5120) return n + 16;
    if (n < 6144) return n + 20;
    if (n < 6160) return 3072 + (n - 6144);
    if (n < 6164) return 5136 + (n - 6160);
    return -1;
}
template <bool WIN>
__device__ __forceinline__ void transpose_item(const float* W, int K, int N, bf16_t* WT, const float* kgain, LAS float* scr, int item, int nblk, int lane) {
    const int kb = item / nblk, nb = item % nblk, k0 = 64 * kb, n0 = 32 * nb;
    const int nd = n0 + (lane & 31); const int sc = WIN ? win_src(nd) : nd;
    float v[32];
    const float* wp = W + (size_t)(k0 + (lane >> 5)) * N + (sc >= 0 ? sc : 0);
#pragma unroll
    for (int i = 0; i < 32; ++i) v[i] = __builtin_nontemporal_load(&wp[(size_t)(2 * i) * N]);
#pragma unroll
    for (int i = 0; i < 32; ++i) { const int kk = 2 * i + (lane >> 5); float t_ = sc >= 0 ? v[i] : 0.f; if (kgain) t_ *= kgain[k0 + kk]; scr[kk * 33 + (lane & 31)] = t_; }
    asm volatile("s_waitcnt lgkmcnt(0)" ::: "memory");
    const int c = lane & 7;
#pragma unroll
    for (int j = 0; j < 4; ++j) { const int n = (lane >> 3) + 8 * j; const LAS float* s = scr + (8 * c) * 33 + n;
        u32x4 o; o.x = pk2(s[0 * 33], s[1 * 33]); o.y = pk2(s[2 * 33], s[3 * 33]); o.z = pk2(s[4 * 33], s[5 * 33]); o.w = pk2(s[6 * 33], s[7 * 33]);
        *(u32x4*)(WT + (size_t)(n0 + n) * K + k0 + 8 * c) = o; }
    asm volatile("s_waitcnt lgkmcnt(0)" ::: "memory");
}
__device__ __forceinline__ void rms_row_to_bf16(const float* xrow, const float* g, bf16_t* orow, int lane) {
    const f32x4* xr = (const f32x4*)xrow + lane; const f32x4* gr = (const f32x4*)g + lane;
    f32x4 v[8]; float s = 0.f;
#pragma unroll
    for (int j = 0; j < 8; ++j) { v[j] = __builtin_nontemporal_load(&xr[64 * j]); s += (v[j].x * v[j].x + v[j].y * v[j].y) + (v[j].z * v[j].z + v[j].w * v[j].w); }
    const float r = 1.0f / sqrtf(wave_sum(s) * (1.0f / DM) + EPS);
    u32x2* o8 = (u32x2*)orow + lane;
#pragma unroll
    for (int j = 0; j < 8; ++j) { const f32x4 gg = gr[64 * j]; u32x2 w; w.x = pk2(v[j].x * r * gg.x, v[j].y * r * gg.y); w.y = pk2(v[j].z * r * gg.z, v[j].w * r * gg.w); o8[64 * j] = w; }
}
__device__ __forceinline__ bf16x8 hn_load(const bf16_t* p, int lane) { return *(const bf16x8*)(p + lane * 8); }
__device__ __forceinline__ void hn_finish(bf16_t* p, bf16x8 v, const float* g, int lane) {
    float f[8]; float ss = 0.f;
#pragma unroll
    for (int e = 0; e < 8; ++e) { f[e] = __uint_as_float((unsigned)(unsigned short)v[e] << 16); ss += f[e] * f[e]; }
    ss += __shfl_xor(ss, 1); ss += __shfl_xor(ss, 2); ss += __shfl_xor(ss, 4); ss += __shfl_xor(ss, 8);
    const float r = __builtin_amdgcn_rsqf(ss * (1.0f / 128.0f) + EPS);
    const f32x4 g0 = *(const f32x4*)(g + (lane & 15) * 8), g1 = *(const f32x4*)(g + (lane & 15) * 8 + 4);
    u32x4 w; w.x = pk2(f[0] * r * g0[0], f[1] * r * g0[1]); w.y = pk2(f[2] * r * g0[2], f[3] * r * g0[3]); w.z = pk2(f[4] * r * g1[0], f[5] * r * g1[1]); w.w = pk2(f[6] * r * g1[2], f[7] * r * g1[3]);
    *(u32x4*)(p + lane * 8) = w;
}
__device__ __forceinline__ float logsig(float z) { return fminf(z, 0.f) - __logf(1.0f + __expf(-fabsf(z))); }


constexpr int LW_OUT = 32 * 64, LW_UP = 32 * 256, LW_DN = 128 * 64, LW_TOTAL = LW_OUT + LW_UP + LW_DN, LW_EARLY = 64 * NWAVES * 11;
__device__ __forceinline__ void late_weights(int it0, int it1, int w, int nw, const float* w_out, const float* w_up, const float* w_dn, const float* mlp_g, bf16_t* Wout_t, bf16_t* Wup_t, bf16_t* Wdn_t, LAS float* scr, int lane) {
    for (int it = it0 + w; it < it1; it += nw) {
        int r = it;
        if (r < LW_OUT) { transpose_item<false>(w_out, DM, DM, Wout_t, nullptr, scr, r, 64, lane); continue; } r -= LW_OUT;
        if (r < LW_UP) { transpose_item<false>(w_up, DM, DFF, Wup_t, mlp_g, scr, r, 256, lane); continue; } r -= LW_UP;
        transpose_item<false>(w_dn, DFF, DM, Wdn_t, nullptr, scr, r, 64, lane);
    }
}

__global__ void __launch_bounds__(NWAVES * 64, 2) hymba_fwd(Args args) {
    extern __shared__ __attribute__((aligned(16))) unsigned char lds_raw[];
    LAS unsigned char* lds = (LAS unsigned char*)lds_raw;
    cg::grid_group grid = cg::this_grid();
    const int tid = threadIdx.x, lane = tid & 63, wave = __builtin_amdgcn_readfirstlane(tid >> 6);
    const int G = gridDim.x, bx = blockIdx.x;
    const int lo = args.ph_lo, hi = args.ph_hi;
    unsigned char* ws = args.ws;
    const float* x = args.in[0]; const float* mem = args.in[1]; const float* attn_g = args.in[2]; const float* w_in = args.in[3];
    const float* gla_w2 = args.in[4]; const float* gla_ab = args.in[5]; const float* fox_fb = args.in[6]; const float* fox_qg = args.in[7]; const float* fox_kg = args.in[8];
    const float* mem_g = args.in[9]; const float* w_mkv = args.in[10]; const float* mem_qg = args.in[11]; const float* mem_kg = args.in[12]; const float* out_g = args.in[13];
    const float* w_out = args.in[14]; const float* mlp_g = args.in[15]; const float* w_up = args.in[16]; const float* w_dn = args.in[17];
    float* out = args.out;
    float* rowsq = (float*)(ws + WS_ROWSQ); float* negc = (float*)(ws + WS_NEGC); float* gates = (float*)(ws + WS_GATES);
    bf16_t* Win_t = (bf16_t*)(ws + WS_WIN); bf16_t* Wout_t = (bf16_t*)(ws + WS_WOUT); bf16_t* Wup_t = (bf16_t*)(ws + WS_WUP); bf16_t* Wdn_t = (bf16_t*)(ws + WS_WDN); bf16_t* Wmkv_t = (bf16_t*)(ws + WS_WMKV);
    bf16_t* MN = (bf16_t*)(ws + WS_MN); bf16_t* MKV = (bf16_t*)(ws + WS_MKV); bf16_t* XN = (bf16_t*)(ws + WS_XN); bf16_t* OG = XN; bf16_t* HB = (bf16_t*)(ws + WS_HB);
    bf16_t* PROJ = (bf16_t*)(ws + WS_BIG); bf16_t* UB = PROJ;
#ifndef PHMASK
#define PHMASK 127
#endif
#define IN(k) (((PHMASK >> (k)) & 1) && lo <= (k) && (k) < hi)
    volatile LAS unsigned* MISC = (volatile LAS unsigned*)(lds + MISC_OFF);
    if (tid < 2) MISC[tid] = 0u;
    __syncthreads();
    XcdBarrier xbar; xbar.bar = (unsigned*)(ws + WS_CTL); xbar.x = 0; xbar.st = MISC;
#define SEAM(k) do { if ((k) != 2 && IN(k) && IN((k) + 1)) { if ((k) == 0) grid.sync(); else xcd_barrier(xbar); } } while (0)
#ifndef REP_PHASE
#define REP_PHASE -1
#endif
#define REPS(k) for (int rep_ = 0; rep_ < (REP_PHASE == (k) ? 2 : 1); ++rep_)

    if (IN(0)) REPS(0) {
        const int gw = bx * NWAVES + wave, NGW = G * NWAVES;
        for (int i = bx * 512 + tid; i < T; i += G * 512) rowsq[i] = 0.f;
        if (bx == 0) { unsigned* ctl = (unsigned*)(ws + WS_CTL); for (int i = tid; i < (int)(CTL_BYTES / 4); i += NWAVES * 64) ctl[i] = 0u; }
        LAS float* scr = (LAS float*)(lds + wave * 16384);
        constexpr int I_IN = 32 * (NINP / 32), I_MKV = 32 * 32;
        for (int it = gw; it < I_IN + I_MKV; it += NGW) {
            int r = it;
            if (r < I_IN) { transpose_item<true>(w_in, DM, NIN, Win_t, nullptr, scr, r, NINP / 32, lane); continue; } r -= I_IN;
            transpose_item<false>(w_mkv, DM, 1024, Wmkv_t, nullptr, scr, r, 32, lane);
        }
        for (int m = gw; m < T; m += NGW) rms_row_to_bf16(x + (size_t)m * DM, attn_g, XN + (size_t)m * DM, lane);
        for (int m = gw; m < TM; m += NGW) rms_row_to_bf16(mem + (size_t)m * DM, mem_g, MN + (size_t)m * DM, lane);
    }
    SEAM(0);
    xbar = xcd_barrier_post((unsigned*)(ws + WS_CTL), MISC);
    if (IN(1)) REPS(1) {
        pg8::OrderTwo S{XN, Win_t, MN, Wmkv_t, T / 256, NINP / 256, TM / 256, 1024 / 256, G, bx};
        pg8::EpiP1 E{PROJ, gates, MKV};
        pg8::gemm_phase<pg8::EpiP1, pg8::OrderTwo>(lds, DM, S, E);
        if (G == 256 && bx >= 192) late_weights(0, LW_EARLY, (bx - 192) * NWAVES + wave, 64 * NWAVES, w_out, w_up, w_dn, mlp_g, Wout_t, Wup_t, Wdn_t, (LAS float*)(lds + wave * 16384), lane);
    }
    SEAM(1);
    if (IN(2)) {
        unsigned* pcnt = (unsigned*)(ws + WS_CTL) + 4096;
        const int vcu0 = (G % 8 == 0) ? (bx % 8) * (G / 8) + bx / 8 : bx;
        for (int v = vcu0; v < 256; v += G) {
            const int j = v & 3, f = v >> 2;
            if (j >= 2) { const int item = f * 2 + (j - 2); gla::run(lds, item >> 3, item & 7, PROJ, gates, gla_w2, gla_ab, out_g, OG); }
            else {
                const int gw = (f * 2 + j) * NWAVES + wave; constexpr int NGW = 128 * NWAVES;
                if (wave == 0 && (f * 2 + j) < 64) {
                    const int bh = f * 2 + j; const float fb = fox_fb[bh & 3];
                    const float* gp = gates + ((size_t)(bh >> 2) * SEQ + lane * 32) * 32 + 16 + (bh & 3);
                    float zz[32]; float run_ = 0.f;
#pragma unroll
                    for (int i = 0; i < 32; ++i) zz[i] = gp[(size_t)i * 32];
#pragma unroll
                    for (int i = 0; i < 32; ++i) { zz[i] = logsig(zz[i] + fb); run_ += zz[i]; }
                    float pre = run_;
#pragma unroll
                    for (int o = 1; o < 64; o <<= 1) { const float t_ = __shfl_up(pre, o); if (lane >= o) pre += t_; }
                    float c = pre - run_;
                    float* np = negc + (size_t)bh * SEQ + lane * 32;
#pragma unroll
                    for (int i = 0; i < 32; i += 4) { f32x4 o4;
#pragma unroll
                        for (int e = 0; e < 4; ++e) { c += zz[i + e]; o4[e] = -c * 11.313708498984761f; }
                        *(f32x4*)(np + i) = o4; }
                }
                for (int m = gw; m < T; m += 4 * NGW) { bf16x8 vv[4][3];
#pragma unroll
                    for (int u = 0; u < 4; ++u) { const int mm = m + u * NGW; if (mm < T) { const bf16_t* p = PROJ + (size_t)mm * LDP; vv[u][0] = hn_load(p + C_FQ, lane); vv[u][1] = hn_load(p + C_FK, lane); vv[u][2] = hn_load(p + C_MQ, lane); } }
#pragma unroll
                    for (int u = 0; u < 4; ++u) { const int mm = m + u * NGW; if (mm < T) { bf16_t* p = PROJ + (size_t)mm * LDP; hn_finish(p + C_FQ, vv[u][0], fox_qg, lane); hn_finish(p + C_FK, vv[u][1], fox_kg, lane); hn_finish(p + C_MQ, vv[u][2], mem_qg, lane); } } }
                for (int m = gw; m < TM; m += 4 * NGW) { bf16x8 vv[4];
#pragma unroll
                    for (int u = 0; u < 4; ++u) { const int mm = m + u * NGW; if (mm < TM) vv[u] = hn_load(MKV + (size_t)mm * 1024, lane); }
#pragma unroll
                    for (int u = 0; u < 4; ++u) { const int mm = m + u * NGW; if (mm < TM) hn_finish(MKV + (size_t)mm * 1024, vv[u], mem_kg, lane); } }
                asm volatile("s_waitcnt vmcnt(0)" ::: "memory"); __syncthreads();
                if (tid == 0) { __builtin_amdgcn_fence(__ATOMIC_RELEASE, "agent"); asm volatile("s_waitcnt vmcnt(0)" ::: "memory"); (void)xb_add(pcnt, 1u); }
                late_weights(G == 256 ? LW_EARLY : 0, LW_TOTAL, gw, NGW, w_out, w_up, w_dn, mlp_g, Wout_t, Wup_t, Wdn_t, (LAS float*)(lds + wave * 16384), lane);
                __syncthreads();
            }
        }
        if (tid == 0) { unsigned sp = 0; while (xb_ld(pcnt) < 128u) { __builtin_amdgcn_s_sleep(2); if (++sp > (1u << 24)) break; }
            __builtin_amdgcn_fence(__ATOMIC_ACQUIRE, "agent"); asm volatile("s_waitcnt vmcnt(0)" ::: "memory"); }
        __syncthreads();
        const att::Ctx c{PROJ, MKV, OG, negc, out_g};
        unsigned* qh = (unsigned*)(ws + WS_CTL) + 4096 + 64;
        const int x0 = (int)(xb_xcc_id() & 7u);
#define GRAB() do { if (tid == 0) { int got = -1; for (int k_ = 0; k_ < 8 && got < 0; ++k_) { const int x_ = (x0 + k_) & 7; \
            const unsigned i_ = xb_add(qh + 64 * x_, 1u); if (i_ < 128u) got = att::queue_id(x_, (int)i_); } MISC[4] = (unsigned)got; } \
            __syncthreads(); } while (0)
        GRAB();
        int cur = __builtin_amdgcn_readfirstlane((int)MISC[4]);
        if (cur >= 0) {
            att::Seam S;
            att::prime(c, cur, (char*)lds_raw, S);
            for (;;) {
                GRAB();
                const int nx = __builtin_amdgcn_readfirstlane((int)MISC[4]); const int nxt = nx >= 0 ? nx : cur;
                if (att::is_fox(cur)) att::block<true>(c, cur, nxt, (char*)lds_raw, S); else att::block<false>(c, cur, nxt, (char*)lds_raw, S);
                if (nx < 0) break;
                cur = nxt;
            }
        }
#undef GRAB
    }
    SEAM(3);
    if (IN(4)) {
        pg8::OrderOne S{OG, Wout_t, T / 256, DM / 256, (T / 256) * (DM / 256), G, bx};
        pg8::EpiP4 E{x, out, HB, rowsq};
        pg8::gemm_phase<pg8::EpiP4, pg8::OrderOne>(lds, DM, S, E);
    }
    SEAM(4);
    if (IN(5)) REPS(5) {
        pg8::OrderOne S{HB, Wup_t, T / 256, DFF / 256, (T / 256) * (DFF / 256), G, bx};
        pg8::EpiP5 E{rowsq, UB};
        pg8::gemm_phase<pg8::EpiP5, pg8::OrderOne>(lds, DM, S, E);
    }
    SEAM(5);
    if (IN(6)) {
        pg8::OrderOne S{UB, Wdn_t, T / 256, DM / 256, (T / 256) * (DM / 256), G, bx};
        pg8::EpiP6 E{HB, out};
        pg8::gemm_phase<pg8::EpiP6, pg8::OrderOne>(lds, DFF, S, E);
    }
#undef IN
#undef SEAM
}

#ifndef MK_PER_PHASE
#define MK_PER_PHASE 0
#endif
extern "C" void kernel_launch(void* const* d_in, const int* in_sizes, int n_in, void* d_out, int out_size, void* d_ws, size_t ws_size, hipStream_t stream) {
    static int grid = 0;
    if (grid == 0) {
        if (n_in != 18 || in_sizes[0] != T * DM || out_size != T * DM || ws_size < WS_END) { fprintf(stderr, "kernel_launch: unexpected shapes (n_in %d, in0 %d, out %d, ws %zu)\n", n_in, n_in > 0 ? in_sizes[0] : -1, out_size, ws_size); grid = -1; return; }
        int dev = 0, cus = 0, per_cu = 0;
        if (hipGetDevice(&dev) != hipSuccess || hipDeviceGetAttribute(&cus, hipDeviceAttributeMultiprocessorCount, dev) != hipSuccess) { grid = -1; return; }
        if (hipFuncSetAttribute((const void*)hymba_fwd, hipFuncAttributeMaxDynamicSharedMemorySize, LDS_BYTES) != hipSuccess) { fprintf(stderr, "kernel_launch: hipFuncSetAttribute failed\n"); grid = -1; return; }
        if (hipOccupancyMaxActiveBlocksPerMultiprocessor(&per_cu, (const void*)hymba_fwd, NWAVES * 64, LDS_BYTES) != hipSuccess || per_cu < 1) { fprintf(stderr, "kernel_launch: occupancy query says %d\n", per_cu); per_cu = 1; }
        (void)hipGetLastError();
        grid = cus * per_cu;
    }
    if (grid < 0) return;
    Args a{};
    for (int i = 0; i < 18; ++i) a.in[i] = (const float*)d_in[i];
    a.out = (float*)d_out; a.ws = (unsigned char*)d_ws;
#if MK_PER_PHASE
    for (int p = 0; p < 7; ++p) { a.ph_lo = p; a.ph_hi = p + 1; hipLaunchKernelGGL(hymba_fwd, dim3(grid), dim3(NWAVES * 64), LDS_BYTES, stream, a); }
#else
    a.ph_lo = 0; a.ph_hi = 7;
    void* kargs[] = {&a};
    hipError_t e = hipLaunchCooperativeKernel((const void*)hymba_fwd, dim3(grid), dim3(NWAVES * 64), kargs, LDS_BYTES, stream);
    if (e != hipSuccess) fprintf(stderr, "kernel_launch: cooperative launch failed: %s (grid %d)\n", hipGetErrorString(e), grid);
#endif
}
```

```cpp
#include <hip/hip_runtime.h>
#include <hip/hip_cooperative_groups.h>
#include <cstdio>
#include <cstdint>
namespace cg = cooperative_groups;

#define LAS __attribute__((address_space(3)))
#define GAS __attribute__((address_space(1)))
typedef unsigned short bf16_t;
typedef short bf16x8 __attribute__((ext_vector_type(8)));
typedef short s16x4 __attribute__((ext_vector_type(4)));
typedef float f32x4 __attribute__((ext_vector_type(4)));
typedef float f32x16 __attribute__((ext_vector_type(16)));
typedef unsigned u32x4 __attribute__((ext_vector_type(4)));
typedef unsigned u32x2 __attribute__((ext_vector_type(2)));

constexpr int NB = 16, SEQ = 2048, DM = 2048, T = NB * SEQ, DFF = 8192, MEMT = 256, TM = NB * MEMT;
constexpr int NIN = 6164, NINP = 6400, LDP = 6144;
constexpr int C_GQ = 0, C_GK = 512, C_GV = 1024, C_GG = 2048, C_FQ = 3072, C_FK = 3584, C_FV = 4096, C_FG = 4608, C_MQ = 5120, C_MG = 5632;
constexpr float EPS = 1e-6f;
constexpr float LOG2E = 1.4426950408889634f;

constexpr size_t MiB = 1u << 20;
constexpr size_t WS_ROWSQ = 0;
constexpr size_t WS_NEGC = 1 * MiB;
constexpr size_t WS_GATES = 2 * MiB;
constexpr size_t WS_CTL = 7 * MiB, CTL_BYTES = 32768;
constexpr size_t WS_WIN = 8 * MiB;
constexpr size_t WS_WOUT = 34 * MiB;
constexpr size_t WS_WUP = 42 * MiB;
constexpr size_t WS_WDN = 74 * MiB;
constexpr size_t WS_WMKV = 106 * MiB;
constexpr size_t WS_MN = 110 * MiB;
constexpr size_t WS_MKV = 126 * MiB;
constexpr size_t WS_XN = 134 * MiB;
constexpr size_t WS_HB = 262 * MiB;
constexpr size_t WS_BIG = 390 * MiB;
constexpr size_t WS_END = 902 * MiB;

namespace pg8 {
constexpr int BM = 256, BK = 64, HALF = 128, HTB = HALF * BK * 2, STAGE_BYTES = 8 * HTB, NXCD = 8, WGM = 8;
__host__ __device__ __forceinline__ int lds_byte(int r, int c) { const int st = (r >> 4) * 2 + (c >> 5), rr = r & 15, cc = c & 31, ob = rr * 64 + cc * 2; return st * 1024 + (ob ^ (((ob >> 9) & 1) << 5)); }
__host__ __device__ __forceinline__ void stage_rc(int b, int& R, int& C) { const int st = b / 1024, sb = b % 1024, swz = sb ^ (((sb >> 9) & 1) << 5); R = (st >> 1) * 16 + swz / 64; C = (st & 1) * 32 + (swz % 64) / 2; }
__host__ __device__ __forceinline__ int perm32(int rho) { const int n = rho >> 4, i = rho & 15; return 8 * (i >> 2) + 4 * n + (i & 3); }

struct Unit { int pm, pn, g; };

__device__ __forceinline__ void tile_of(int wgid, int nM, int nN, int& pm, int& pn) {
    const int nwg = nM * nN;
    { const int q = nwg / NXCD, r = nwg % NXCD, xcd = wgid % NXCD, off = wgid / NXCD; wgid = (xcd < r ? xcd * (q + 1) : r * (q + 1) + (xcd - r) * q) + off; }
    const int nig = WGM * nN, gid = wgid / nig, fm = gid * WGM, gsz = (nM - fm) < WGM ? (nM - fm) : WGM;
    pm = fm + ((wgid % nig) % gsz); pn = (wgid % nig) / gsz;
}
struct OrderOne {
    const bf16_t* A; const bf16_t* Bt; int nM, nN, nwg, G, c;
    __device__ __forceinline__ bool next(int i, Unit& u) const { const long L = (long)i * G + c; if (L >= nwg) return false; tile_of((int)L, nM, nN, u.pm, u.pn); u.g = 0; return true; }
    __device__ __forceinline__ const char* abase(const Unit& u, size_t tstep) const { return (const char*)A + (size_t)u.pm * tstep; }
    __device__ __forceinline__ const char* bbase(const Unit& u, size_t tstep) const { return (const char*)Bt + (size_t)u.pn * tstep; }
};
struct OrderTwo {
    const bf16_t* A0; const bf16_t* B0; const bf16_t* A1; const bf16_t* B1; int nM0, nN0, nM1, nN1, G, c;
    __device__ __forceinline__ bool next(int i, Unit& u) const {
        long L = (long)i * G + c; const int n0 = nM0 * nN0;
        if (L < n0) { tile_of((int)L, nM0, nN0, u.pm, u.pn); u.g = 0; return true; }
        L -= n0; if (L >= nM1 * nN1) return false;
        u.pm = (int)L / nN1; u.pn = (int)L % nN1; u.g = 1; return true;
    }
    __device__ __forceinline__ const char* abase(const Unit& u, size_t tstep) const { return (const char*)(u.g ? A1 : A0) + (size_t)u.pm * tstep; }
    __device__ __forceinline__ const char* bbase(const Unit& u, size_t tstep) const { return (const char*)(u.g ? B1 : B0) + (size_t)u.pn * tstep; }
};

__device__ __forceinline__ unsigned cvt_pk_bf16(float lo, float hi) { unsigned r; asm volatile("v_cvt_pk_bf16_f32 %0, %1, %2" : "=v"(r) : "v"(lo), "v"(hi)); return r; }

template <class Epi, class Sched, bool ALIGN_EPI = true, bool SP2 = true>
__device__ __forceinline__ void gemm_phase(LAS unsigned char* lds, const int K, const Sched& S, const Epi& E) {
    const int tid = threadIdx.x, wid = __builtin_amdgcn_readfirstlane(tid >> 6), lane = tid & 63, wr = wid >> 2, wc = wid & 3, fr = lane & 15, fq = lane >> 4;
    const int nt = K / BK;
    unsigned voffA[2], voffB[2];
#pragma unroll
    for (int i = 0; i < 2; ++i) { int R, C; stage_rc(tid * 16 + i * 8192, R, C); const int Rb = Epi::PERM ? ((R & ~31) + perm32(R & 31)) : R;
        voffA[i] = (unsigned)(R * K + C) * 2u; voffB[i] = (unsigned)(Rb * K + C) * 2u; }
    const size_t kstep = (size_t)(BK * 2);
    const size_t hstep = (size_t)HALF * K * 2;
    const size_t tstep = 2 * hstep;
    const unsigned ldsw = (unsigned)wid * 1024u;
    const int aoff = lds_byte(wr * 64 + fr, fq * 8), boff = lds_byte(wc * 32 + fr, fq * 8);
#define PG8_SA(b, h) (((b) * 2 + (h)) * HTB)
#define PG8_SB(b, h) ((4 + (b) * 2 + (h)) * HTB)
#define PG8_STAGE(bufoff, gbase, voff) do { _Pragma("unroll") for (int _i = 0; _i < 2; ++_i) \
        __builtin_amdgcn_global_load_lds((const unsigned*)((const char*)(gbase) + (voff)[_i]), (LAS unsigned*)(lds + (bufoff) + ldsw + _i * 8192), 16, 0, 0); } while (0)
#define PG8_LDA(dst, b, h) do { _Pragma("unroll") for (int m = 0; m < 4; ++m) _Pragma("unroll") for (int k = 0; k < 2; ++k) dst[m][k] = *(const LAS bf16x8*)(lds + PG8_SA(b, h) + aoff + m * 2048 + k * 1024); } while (0)
#define PG8_LDB(dst, b, h) do { _Pragma("unroll") for (int n = 0; n < 2; ++n) _Pragma("unroll") for (int k = 0; k < 2; ++k) dst[n][k] = *(const LAS bf16x8*)(lds + PG8_SB(b, h) + boff + n * 2048 + k * 1024); } while (0)
#define PG8_MMA(ai, bj, At, Bt) do { __builtin_amdgcn_s_setprio(1); _Pragma("unroll") for (int m = 0; m < 4; ++m) _Pragma("unroll") for (int n = 0; n < 2; ++n) _Pragma("unroll") for (int k = 0; k < 2; ++k) \
        acc[ai][bj][m][n] = __builtin_amdgcn_mfma_f32_16x16x32_bf16(Bt[n][k], At[m][k], acc[ai][bj][m][n], 0, 0, 0); __builtin_amdgcn_s_setprio(0); } while (0)
#define PG8_WAIT_V(n) asm volatile("s_waitcnt vmcnt(" #n ")" ::: "memory")
#define PG8_WAIT_L(n) asm volatile("s_waitcnt lgkmcnt(" #n ")" ::: "memory")
#define PG8_BAR __builtin_amdgcn_s_barrier()
#define PG8_SCHED __builtin_amdgcn_sched_barrier(0)
    Unit cur, nxt; int ui = 0;
    if (!S.next(0, cur)) return;
    f32x4 acc[2][2][4][2];
#pragma unroll
    for (int a = 0; a < 2; ++a)
#pragma unroll
        for (int b = 0; b < 2; ++b)
#pragma unroll
            for (int m = 0; m < 4; ++m)
#pragma unroll
                for (int n = 0; n < 2; ++n) acc[a][b][m][n] = (f32x4){0.f, 0.f, 0.f, 0.f};
    bf16x8 At[4][2], B0[2][2], B1[2][2];
    const char* cA = S.abase(cur, tstep); const char* cB = S.bbase(cur, tstep);
    if constexpr (SP2) {
        PG8_STAGE(PG8_SB(0, 0), cB, voffB); PG8_STAGE(PG8_SB(0, 1), cB + hstep, voffB); PG8_STAGE(PG8_SA(0, 0), cA, voffA); PG8_STAGE(PG8_SA(0, 1), cA + hstep, voffA);
        if (wr == 1) PG8_BAR;
        PG8_WAIT_V(2); PG8_BAR;
        PG8_STAGE(PG8_SB(1, 0), cB + kstep, voffB); PG8_STAGE(PG8_SA(1, 0), cA + kstep, voffA); PG8_STAGE(PG8_SB(1, 1), cB + hstep + kstep, voffB);
        PG8_WAIT_V(6); PG8_BAR;
    } else {
        PG8_STAGE(PG8_SB(0, 0), cB, voffB); PG8_STAGE(PG8_SA(0, 0), cA, voffA); PG8_STAGE(PG8_SB(0, 1), cB + hstep, voffB); PG8_STAGE(PG8_SA(0, 1), cA + hstep, voffA);
        if (wr == 1) PG8_BAR;
        PG8_WAIT_V(4); PG8_BAR;
        PG8_STAGE(PG8_SB(1, 0), cB + kstep, voffB); PG8_STAGE(PG8_SA(1, 0), cA + kstep, voffA); PG8_STAGE(PG8_SB(1, 1), cB + hstep + kstep, voffB);
        PG8_WAIT_V(6); PG8_BAR;
    }
    for (;;) {
        const bool has_next = S.next(ui + 1, nxt);
        const char* nA = has_next ? S.abase(nxt, tstep) : cA; const char* nB = has_next ? S.bbase(nxt, tstep) : cB;
        for (int t = 0; t < nt; t += 2) {
            const bool last = (t == nt - 2);
            const char* a1 = cA + (size_t)(t + 1) * kstep;
            const char* a2 = last ? nA : cA + (size_t)(t + 2) * kstep; const char* b2 = last ? nB : cB + (size_t)(t + 2) * kstep;
            const char* a3 = a2 + kstep; const char* b3 = b2 + kstep;
            if constexpr (SP2) {
            PG8_LDB(B0, 0, 0); PG8_LDB(B1, 0, 1); PG8_SCHED; PG8_LDA(At, 0, 0); PG8_STAGE(PG8_SA(1, 1), a1 + hstep, voffA);
            PG8_WAIT_V(8); PG8_WAIT_L(0); PG8_BAR; PG8_MMA(0, 0, At, B0); PG8_MMA(0, 1, At, B1); PG8_BAR; PG8_SCHED;
            PG8_LDA(At, 0, 1); PG8_STAGE(PG8_SB(0, 0), b2, voffB); PG8_STAGE(PG8_SB(0, 1), b2 + hstep, voffB); PG8_STAGE(PG8_SA(0, 0), a2, voffA);
            PG8_WAIT_V(8); PG8_WAIT_L(0); PG8_BAR; PG8_MMA(1, 0, At, B0); PG8_MMA(1, 1, At, B1); PG8_BAR; PG8_SCHED;
            PG8_LDB(B0, 1, 0); PG8_LDB(B1, 1, 1); PG8_SCHED; PG8_LDA(At, 1, 0); PG8_STAGE(PG8_SA(0, 1), a2 + hstep, voffA);
            PG8_WAIT_V(8); PG8_WAIT_L(0); PG8_BAR; PG8_MMA(0, 0, At, B0); PG8_MMA(0, 1, At, B1); PG8_BAR; PG8_SCHED;
            PG8_LDA(At, 1, 1); PG8_STAGE(PG8_SB(1, 0), b3, voffB); PG8_STAGE(PG8_SB(1, 1), b3 + hstep, voffB); PG8_STAGE(PG8_SA(1, 0), a3, voffA);
            PG8_WAIT_V(8); PG8_WAIT_L(0); PG8_BAR; PG8_MMA(1, 0, At, B0); PG8_MMA(1, 1, At, B1); PG8_BAR; PG8_SCHED;
            } else {
            PG8_LDB(B0, 0, 0); PG8_SCHED; PG8_LDA(At, 0, 0); PG8_STAGE(PG8_SA(1, 1), a1 + hstep, voffA);
            PG8_WAIT_L(8); PG8_BAR; PG8_WAIT_L(0); PG8_MMA(0, 0, At, B0); PG8_BAR; PG8_SCHED;
            PG8_LDB(B1, 0, 1); PG8_STAGE(PG8_SB(0, 0), b2, voffB);
            PG8_BAR; PG8_WAIT_L(0); PG8_MMA(0, 1, At, B1); PG8_BAR;
            PG8_LDA(At, 0, 1); PG8_STAGE(PG8_SA(0, 0), a2, voffA);
            PG8_BAR; PG8_WAIT_L(0); PG8_MMA(1, 0, At, B0); PG8_BAR; PG8_SCHED;
            PG8_STAGE(PG8_SB(0, 1), b2 + hstep, voffB);
            PG8_WAIT_V(6); PG8_BAR; PG8_MMA(1, 1, At, B1); PG8_BAR;
            PG8_LDB(B0, 1, 0); PG8_SCHED; PG8_LDA(At, 1, 0); PG8_STAGE(PG8_SA(0, 1), a2 + hstep, voffA);
            PG8_WAIT_L(8); PG8_BAR; PG8_WAIT_L(0); PG8_MMA(0, 0, At, B0); PG8_BAR; PG8_SCHED;
            PG8_LDB(B1, 1, 1); PG8_STAGE(PG8_SB(1, 0), b3, voffB);
            PG8_BAR; PG8_WAIT_L(0); PG8_MMA(0, 1, At, B1); PG8_BAR;
            PG8_LDA(At, 1, 1); PG8_STAGE(PG8_SA(1, 0), a3, voffA);
            PG8_BAR; PG8_WAIT_L(0); PG8_MMA(1, 0, At, B0); PG8_BAR; PG8_SCHED;
            PG8_STAGE(PG8_SB(1, 1), b3 + hstep, voffB);
            PG8_WAIT_V(6); PG8_BAR; PG8_MMA(1, 1, At, B1); PG8_BAR;
            }
        }
        if constexpr (ALIGN_EPI) { if (wr == 0) PG8_BAR; }
        E(acc, cur, wr, wc, fr, fq);
        if (!has_next) break;
#pragma unroll
        for (int a = 0; a < 2; ++a)
#pragma unroll
            for (int b = 0; b < 2; ++b)
#pragma unroll
                for (int m = 0; m < 4; ++m)
#pragma unroll
                    for (int n = 0; n < 2; ++n) acc[a][b][m][n] = (f32x4){0.f, 0.f, 0.f, 0.f};
        cur = nxt; cA = nA; cB = nB; ++ui;
        if constexpr (ALIGN_EPI) { if (wr == 1) PG8_BAR; }
    }
    PG8_WAIT_V(0);
    if constexpr (!ALIGN_EPI) { if (wr == 0) PG8_BAR; }
    PG8_BAR;
#undef PG8_SA
#undef PG8_SB
#undef PG8_STAGE
#undef PG8_LDA
#undef PG8_LDB
#undef PG8_MMA
#undef PG8_WAIT_V
#undef PG8_WAIT_L
#undef PG8_BAR
#undef PG8_SCHED
}

__device__ __forceinline__ u32x4 pack8(f32x4 a, f32x4 b) { u32x4 w; w.x = cvt_pk_bf16(a[0], a[1]); w.y = cvt_pk_bf16(a[2], a[3]); w.z = cvt_pk_bf16(b[0], b[1]); w.w = cvt_pk_bf16(b[2], b[3]); return w; }

struct EpiP1 {
    static constexpr bool PERM = true;
    bf16_t* proj; float* gates; bf16_t* mkv;
    __device__ __forceinline__ void operator()(const f32x4 (&acc)[2][2][4][2], const Unit& u, int wr, int wc, int fr, int fq) const {
        const int row0 = u.pm * BM + wr * 64 + fr;
        if (u.g == 0 && u.pn == 24) {
            if (wc == 0) {
#pragma unroll
                for (int ai = 0; ai < 2; ++ai)
#pragma unroll
                    for (int m = 0; m < 4; ++m) { float* p = gates + (size_t)(row0 + ai * HALF + m * 16) * 32 + 8 * fq; *(f32x4*)p = acc[ai][0][m][0]; *(f32x4*)(p + 4) = acc[ai][0][m][1]; }
            }
            return;
        }
        bf16_t* base = u.g ? mkv : proj; const int ldc = u.g ? 1024 : LDP;
        const int col0 = u.pn * BM + wc * 32 + 8 * fq;
#pragma unroll
        for (int ai = 0; ai < 2; ++ai)
#pragma unroll
            for (int m = 0; m < 4; ++m) { bf16_t* rowp = base + (size_t)(row0 + ai * HALF + m * 16) * ldc + col0;
#pragma unroll
                for (int bj = 0; bj < 2; ++bj) *(u32x4*)(rowp + bj * HALF) = pack8(acc[ai][bj][m][0], acc[ai][bj][m][1]); }
    }
};
struct EpiP4 {
    static constexpr bool PERM = true;
    const float* __restrict__ x; float* out; bf16_t* __restrict__ hb; float* rowsq;
    __device__ __forceinline__ void operator()(const f32x4 (&acc)[2][2][4][2], const Unit& u, int wr, int wc, int fr, int fq) const {
        const int row0 = u.pm * BM + wr * 64 + fr; const int col0 = u.pn * BM + wc * 32 + 8 * fq;
        float ssv[2][4];
        f32x4 xa[4], xb[4];
#define LDX(dst, ai_, m_) do { const size_t o_ = (size_t)(row0 + (ai_) * HALF + (m_) * 16) * DM + col0; dst[0] = *(const f32x4*)(x + o_); dst[1] = *(const f32x4*)(x + o_ + 4); dst[2] = *(const f32x4*)(x + o_ + HALF); dst[3] = *(const f32x4*)(x + o_ + HALF + 4); } while (0)
#define DOX(src, ai_, m_) do { const size_t o_ = (size_t)(row0 + (ai_) * HALF + (m_) * 16) * DM + col0; float ss = 0.f; \
            _Pragma("unroll") for (int bj = 0; bj < 2; ++bj) { const f32x4 h0 = src[2 * bj] + acc[ai_][bj][m_][0], h1 = src[2 * bj + 1] + acc[ai_][bj][m_][1]; \
                *(u32x4*)(hb + o_ + bj * HALF) = pack8(h0, h1); \
                ss += (h0[0] * h0[0] + h0[1] * h0[1]) + (h0[2] * h0[2] + h0[3] * h0[3]) + (h1[0] * h1[0] + h1[1] * h1[1]) + (h1[2] * h1[2] + h1[3] * h1[3]); } \
            ssv[ai_][m_] = ss; } while (0)
#define SB_ __builtin_amdgcn_sched_barrier(0)
        LDX(xa, 0, 0); LDX(xb, 0, 1); SB_;
        DOX(xa, 0, 0); SB_; LDX(xa, 0, 2); SB_; DOX(xb, 0, 1); SB_; LDX(xb, 0, 3); SB_;
        DOX(xa, 0, 2); SB_; LDX(xa, 1, 0); SB_; DOX(xb, 0, 3); SB_; LDX(xb, 1, 1); SB_;
        DOX(xa, 1, 0); SB_; LDX(xa, 1, 2); SB_; DOX(xb, 1, 1); SB_; LDX(xb, 1, 3); SB_;
        DOX(xa, 1, 2); SB_; DOX(xb, 1, 3); SB_;
#undef SB_
#undef LDX
#undef DOX
#pragma unroll
        for (int ai = 0; ai < 2; ++ai)
#pragma unroll
            for (int m = 0; m < 4; ++m) { float ss = ssv[ai][m]; ss += __shfl_xor(ss, 16); ss += __shfl_xor(ss, 32); if (fq == 0) atomicAdd(rowsq + row0 + ai * HALF + m * 16, ss); }
    }
};
struct EpiP5 {
    static constexpr bool PERM = true;
    const float* rowsq; bf16_t* ub;
    __device__ __forceinline__ void operator()(const f32x4 (&acc)[2][2][4][2], const Unit& u, int wr, int wc, int fr, int fq) const {
        const int row0 = u.pm * BM + wr * 64 + fr; const int col0 = u.pn * BM + wc * 32 + 8 * fq;
        float rq[2][4];
#pragma unroll
        for (int ai = 0; ai < 2; ++ai)
#pragma unroll
            for (int m = 0; m < 4; ++m) rq[ai][m] = rowsq[row0 + ai * HALF + m * 16];
        __builtin_amdgcn_sched_barrier(0);
#pragma unroll
        for (int ai = 0; ai < 2; ++ai)
#pragma unroll
            for (int m = 0; m < 4; ++m) { const int row = row0 + ai * HALF + m * 16; const float r = __builtin_amdgcn_rsqf(rq[ai][m] * (1.0f / DM) + EPS);
                bf16_t* rowp = ub + (size_t)row * DFF + col0;
                const float r2 = r * r;
#pragma unroll
                for (int bj = 0; bj < 2; ++bj) { f32x4 a = acc[ai][bj][m][0], b = acc[ai][bj][m][1];
#pragma unroll
                    for (int e = 0; e < 4; ++e) { a[e] = fmaxf(a[e], 0.f); b[e] = fmaxf(b[e], 0.f); }
                    a = (a * a) * r2; b = (b * b) * r2;
                    *(u32x4*)(rowp + bj * HALF) = pack8(a, b); } }
    }
};
struct EpiP6 {
    static constexpr bool PERM = true;
    const bf16_t* hb; float* out;
    __device__ __forceinline__ void operator()(const f32x4 (&acc)[2][2][4][2], const Unit& u, int wr, int wc, int fr, int fq) const {
        const int row0 = u.pm * BM + wr * 64 + fr; const int col0 = u.pn * BM + wc * 32 + 8 * fq;
        u32x4 hv[2][4][2];
#pragma unroll
        for (int ai = 0; ai < 2; ++ai)
#pragma unroll
            for (int m = 0; m < 4; ++m) { const size_t off = (size_t)(row0 + ai * HALF + m * 16) * DM + col0; hv[ai][m][0] = *(const u32x4*)(hb + off); hv[ai][m][1] = *(const u32x4*)(hb + off + HALF); }
        __builtin_amdgcn_sched_barrier(0);
#pragma unroll
        for (int ai = 0; ai < 2; ++ai)
#pragma unroll
            for (int m = 0; m < 4; ++m) { const size_t off = (size_t)(row0 + ai * HALF + m * 16) * DM + col0;
#pragma unroll
                for (int bj = 0; bj < 2; ++bj) { const u32x4 w = hv[ai][m][bj];
                    f32x4 h0, h1;
                    h0[0] = __uint_as_float(w.x << 16); h0[1] = __uint_as_float(w.x & 0xffff0000u); h0[2] = __uint_as_float(w.y << 16); h0[3] = __uint_as_float(w.y & 0xffff0000u);
                    h1[0] = __uint_as_float(w.z << 16); h1[1] = __uint_as_float(w.z & 0xffff0000u); h1[2] = __uint_as_float(w.w << 16); h1[3] = __uint_as_float(w.w & 0xffff0000u);
                    *(f32x4*)(out + off + bj * HALF) = h0 + acc[ai][bj][m][0]; *(f32x4*)(out + off + bj * HALF + 4) = h1 + acc[ai][bj][m][1]; } }
    }
};
}

namespace att {
constexpr int D = 128, NW = 8, QBLK = 32, KVBLK = 64, QB = NW * QBLK;
constexpr int SHM_V = KVBLK * D * 2, SHM_K = KVBLK * D * 2;
constexpr int LDS_WS = 2 * SHM_V + 2 * SHM_K;
constexpr int LDS_NEGC = LDS_WS + NW * 64 * 4;
constexpr int LDS_STG = LDS_NEGC + 2048 * 4;
constexpr int SP = 132;
constexpr int LDS_BYTES = LDS_STG + NW * 16 * SP * 4;
constexpr float SCALE = 0.08838834764831845f;
constexpr float THR = 8.f;
#define KSWZ(row, colB) ((row) * 256 + ((colB) ^ (((row) & 7) << 4)))
#define SBAR() __builtin_amdgcn_sched_barrier(0)
__device__ __forceinline__ int v_st(int k, int c) { const int kk = (k & ~0xC) | ((k & 4) << 1) | ((k & 8) >> 1); return ((kk >> 3) * 4 + (c >> 5)) * 512 + ((kk & 7) * 32 + (c & 31)) * 2; }
__device__ __forceinline__ int v_rd_base(int lane) { return ((lane & 3) << 3) | (((lane >> 2) & 3) << 6) | (((lane >> 4) & 1) << 5) | (((lane >> 5) & 1) << 8); }
constexpr int v_rd_off(int d0, int ks, int half) { return d0 * 512 + ks * 4096 + half * 2048; }
__device__ __forceinline__ int crow(int r, int hi) { return (r & 3) + 8 * (r >> 2) + 4 * hi; }
__device__ __forceinline__ unsigned cvtpk(float lo, float hi) { unsigned r; asm volatile("v_cvt_pk_bf16_f32 %0, %1, %2" : "=v"(r) : "v"(lo), "v"(hi)); return r; }
__device__ __forceinline__ bf16x8 ld8(const bf16_t* p) { return *reinterpret_cast<const bf16x8*>(p); }
__device__ __forceinline__ float bf2f(unsigned short b) { return __uint_as_float((unsigned)b << 16); }

__device__ __forceinline__ void mask_tile(f32x16& p0, f32x16& p1, int dq) {
    const float NEG = -__builtin_inff();
#pragma unroll
    for (int r = 0; r < 16; ++r) {
        const int c = (r & 3) + 8 * (r >> 2);
        if (dq - c < 0) p0[r] = NEG;
        if (dq - c - 32 < 0) p1[r] = NEG;
    }
}
__device__ __forceinline__ void partialSM(f32x16& p0, f32x16& p1, float& m_reg, float& mn, float& alpha) {
    float pmax = p0[0];
#pragma unroll
    for (int r = 1; r < 16; ++r) pmax = fmaxf(pmax, p0[r]);
#pragma unroll
    for (int r = 0; r < 16; ++r) pmax = fmaxf(pmax, p1[r]);
    { auto rr = __builtin_amdgcn_permlane32_swap(__float_as_uint(pmax), __float_as_uint(pmax), false, false);
      pmax = fmaxf(__uint_as_float(rr[0]), __uint_as_float(rr[1])); }
    constexpr float C2 = 1.4426950408889634f * SCALE;
    if (__builtin_expect(__all((pmax - m_reg) * SCALE <= THR), 1)) { mn = m_reg; alpha = 1.f; }
    else { mn = fmaxf(m_reg, pmax); alpha = __builtin_amdgcn_exp2f((m_reg - mn) * C2); m_reg = mn; }
    const float mnL = -mn * C2;
#pragma unroll
    for (int r = 0; r < 16; ++r) p0[r] = fmaf(p0[r], C2, mnL);
#pragma unroll
    for (int r = 0; r < 16; ++r) p1[r] = fmaf(p1[r], C2, mnL);
#pragma unroll
    for (int r = 0; r < 16; ++r) p0[r] = __builtin_amdgcn_exp2f(p0[r]);
}
__device__ __forceinline__ void finishSM(f32x16& p0, f32x16& p1, float alpha, float& l_reg, bf16x8& pa0, bf16x8& pa1, bf16x8& pa2, bf16x8& pa3) {
#pragma unroll
    for (int r = 0; r < 16; ++r) p1[r] = __builtin_amdgcn_exp2f(p1[r]);
    float ps = 0;
#pragma unroll
    for (int r = 0; r < 16; ++r) ps += p0[r];
#pragma unroll
    for (int r = 0; r < 16; ++r) ps += p1[r];
    { auto rr = __builtin_amdgcn_permlane32_swap(__float_as_uint(ps), __float_as_uint(ps), false, false);
      ps = __uint_as_float(rr[0]) + __uint_as_float(rr[1]); }
    l_reg = l_reg * alpha + ps;
#define PK4(P, B_, OUT) do { unsigned a0 = cvtpk(P[B_+0], P[B_+1]), a1 = cvtpk(P[B_+2], P[B_+3]);                          \
        unsigned b0 = cvtpk(P[B_+4], P[B_+5]), b1 = cvtpk(P[B_+6], P[B_+7]);                                             \
        auto r0 = __builtin_amdgcn_permlane32_swap(a0, b0, false, false); auto r1 = __builtin_amdgcn_permlane32_swap(a1, b1, false, false); \
        u32x4 w = {r0[0], r1[0], r0[1], r1[1]}; OUT = *reinterpret_cast<bf16x8*>(&w); } while (0)
    PK4(p0, 0, pa0); PK4(p0, 8, pa1); PK4(p1, 0, pa2); PK4(p1, 8, pa3);
#undef PK4
}
template <int KB, bool BIAS>
__device__ __forceinline__ void qkt(f32x16& p0, f32x16& p1, const char* K_lds, int r32, int hi, const bf16x8* qr, const LAS float* nb) {
    if (BIAS) {
#pragma unroll
        for (int g = 0; g < 4; ++g) { const f32x4 a = *(const LAS f32x4*)(nb + 8 * g), b = *(const LAS f32x4*)(nb + 8 * g + 32);
            p0[4 * g] = a[0]; p0[4 * g + 1] = a[1]; p0[4 * g + 2] = a[2]; p0[4 * g + 3] = a[3];
            p1[4 * g] = b[0]; p1[4 * g + 1] = b[1]; p1[4 * g + 2] = b[2]; p1[4 * g + 3] = b[3]; }
    } else { p0 = f32x16{}; p1 = f32x16{}; }
    const char* kb[4];
#pragma unroll
    for (int dd = 0; dd < 4; ++dd) kb[dd] = K_lds + KB * SHM_K + KSWZ(r32, (dd * 16 + hi * 8) * 2);
#pragma unroll
    for (int d0 = 0; d0 < 8; ++d0) { const char* a = kb[d0 & 3] + (d0 >> 2) * 128;
        bf16x8 b0 = *reinterpret_cast<const bf16x8*>(a);
        bf16x8 b1 = *reinterpret_cast<const bf16x8*>(a + 32 * 256);
        p0 = __builtin_amdgcn_mfma_f32_32x32x16_bf16(b0, qr[d0], p0, 0, 0, 0);
        p1 = __builtin_amdgcn_mfma_f32_32x32x16_bf16(b1, qr[d0], p1, 0, 0, 0); }
}
template <int VB>
__device__ __forceinline__ void pv_tile(f32x16* o, int vb0, bf16x8 pa0, bf16x8 pa1, bf16x8 pa2, bf16x8 pa3) {
#define TRRD(dst, off) asm volatile("ds_read_b64_tr_b16 %0, %1 offset:%2" : "=&v"(dst) : "v"(vb0), "i"(off) : "memory")
#define PV_D0(d0) do { s16x4 l0, l1, l2, l3, h0, h1, h2, h3; constexpr int b_ = VB * SHM_V + v_rd_off(d0, 0, 0); \
        TRRD(l0, b_); TRRD(h0, b_ + 2048); TRRD(l1, b_ + 4096); TRRD(h1, b_ + 6144); TRRD(l2, b_ + 8192); TRRD(h2, b_ + 10240); TRRD(l3, b_ + 12288); TRRD(h3, b_ + 14336); \
        asm volatile("s_waitcnt lgkmcnt(0)" ::: "memory"); SBAR();   \
        o[d0] = __builtin_amdgcn_mfma_f32_32x32x16_bf16(pa0, (bf16x8){l0[0], l0[1], l0[2], l0[3], h0[0], h0[1], h0[2], h0[3]}, o[d0], 0, 0, 0);   \
        o[d0] = __builtin_amdgcn_mfma_f32_32x32x16_bf16(pa1, (bf16x8){l1[0], l1[1], l1[2], l1[3], h1[0], h1[1], h1[2], h1[3]}, o[d0], 0, 0, 0);   \
        o[d0] = __builtin_amdgcn_mfma_f32_32x32x16_bf16(pa2, (bf16x8){l2[0], l2[1], l2[2], l2[3], h2[0], h2[1], h2[2], h2[3]}, o[d0], 0, 0, 0);   \
        o[d0] = __builtin_amdgcn_mfma_f32_32x32x16_bf16(pa3, (bf16x8){l3[0], l3[1], l3[2], l3[3], h3[0], h3[1], h3[2], h3[3]}, o[d0], 0, 0, 0); } while (0)
    PV_D0(0); PV_D0(1); PV_D0(2); PV_D0(3);
#undef PV_D0
#undef TRRD
}

struct Ctx { const bf16_t* proj; const bf16_t* mkv; bf16_t* og; const float* negc; const float* outg; };
constexpr int NFOX = 64 * 8, NMEMB = 64 * 8;
__device__ __forceinline__ bool is_fox(int id) { return id < NFOX; }
__device__ __forceinline__ void dec(int id, int& b, int& h, int& qb) { const int m = id & (NFOX - 1), bh = m >> 3; qb = m & 7; b = bh >> 2; h = bh & 3; }
__device__ __forceinline__ int queue_id(int x, int i) { if (i < 64) return (8 * x + (i & 7)) * 8 + (7 - (i >> 3)); const int m = i - 64; return NFOX + (8 * x + (m >> 3)) * 8 + (m & 7); }
__device__ __forceinline__ int bin_len(int j) { return j == 3 ? 7 : 3; }
__device__ __forceinline__ int bin_id(int j, int f, int s) {
    if (s < 2) { const int qb = (j == 0) ? (s == 0 ? 7 : 4) : (j == 1) ? (s == 0 ? 6 : 5) : (j == 2) ? (s == 0 ? 3 : 2) : (s == 0 ? 1 : 0); return f * 8 + qb; }
    return NFOX + f * 8 + (j == 3 ? 3 + (s - 2) : j);
}
__device__ __forceinline__ void kv_of(const Ctx& c, int id, const char*& K, const char*& V, int& ldkv) {
    int b, h, qb; dec(id, b, h, qb);
    if (is_fox(id)) { const bf16_t* pb = c.proj + (size_t)b * SEQ * LDP; K = (const char*)(pb + C_FK + h * 128); V = (const char*)(pb + C_FV + h * 128); ldkv = LDP; }
    else { const bf16_t* kvb = c.mkv + (size_t)b * MEMT * 1024; K = (const char*)(kvb + h * 128); V = (const char*)(kvb + 512 + h * 128); ldkv = 1024; }
}
__device__ __forceinline__ const char* q_of(const Ctx& c, int id) {
    int b, h, qb; dec(id, b, h, qb);
    return (const char*)(c.proj + ((size_t)b * SEQ + (size_t)qb * 256) * LDP + (is_fox(id) ? C_FQ : C_MQ) + h * 128);
}
struct Seam { bf16x8 qr[8]; bf16x8 st_v0, st_v1, st_k0, st_k1; };
#define VMW() asm volatile("s_waitcnt vmcnt(0)" ::: "memory")
#define VMWN(n) asm volatile("s_waitcnt vmcnt(%0)" :: "i"(n) : "memory")
#define LD16(base, voff) (*reinterpret_cast<const bf16x8*>((base) + (voff)))
#define SLOAD_H(Kp, Vp, ld, o0, o1, k0) do { const size_t tb_ = (size_t)(k0) * (ld) * 2; S.st_v0 = LD16((Vp) + tb_, o0); S.st_v1 = LD16((Vp) + tb_, o1); S.st_k0 = LD16((Kp) + tb_, o0); S.st_k1 = LD16((Kp) + tb_, o1); } while (0)
#define SWRITE_HK(bf) do { *(bf16x8*)(K_lds + (bf) * SHM_K + kws) = S.st_k0; *(bf16x8*)(K_lds + (bf) * SHM_K + kws + 32 * 256) = S.st_k1; } while (0)
#define SWRITE_HV(bf) do { *(bf16x8*)(V_lds + (bf) * SHM_V + vst0) = S.st_v0; *(bf16x8*)(V_lds + (bf) * SHM_V + vst1) = S.st_v1; } while (0)
#define SWRITE_H(bf) do { SWRITE_HV(bf); SWRITE_HK(bf); } while (0)
__device__ __forceinline__ void load_q(Seam& S, const char* Qb, int wid, int r32, int hi) {
    const unsigned qo = (unsigned)(((wid * QBLK + r32) * LDP + hi * 8) * 2);
#pragma unroll
    for (int d0 = 0; d0 < 8; ++d0) S.qr[d0] = LD16(Qb, qo + d0 * 32);
}
__device__ __forceinline__ void prime(const Ctx& c, int id, char* lds, Seam& S) {
    const int tid = threadIdx.x, wid = __builtin_amdgcn_readfirstlane(tid >> 6), lane = tid & 63, r32 = lane & 31, hi = lane >> 5;
    const int sr = tid >> 4, sc = (tid & 15) * 8, kws = KSWZ(sr, sc * 2); char* K_lds = lds + 2 * SHM_V;
    load_q(S, q_of(c, id), wid, r32, hi);
    const char* Kh; const char* Vh; int ldkv; kv_of(c, id, Kh, Vh, ldkv);
    const unsigned o0 = (unsigned)((sr * ldkv + sc) * 2), o1 = o0 + (unsigned)(32 * ldkv * 2);
    SLOAD_H(Kh, Vh, ldkv, o0, o1, 0); VMW(); SWRITE_HK(0);
    __syncthreads();
}
template <bool FOX>
__device__ __forceinline__ void block(const Ctx& c, const int id, const int nid, char* lds, Seam& S) {
    int tid = threadIdx.x; asm volatile("" : "+v"(tid));
    const int wid = __builtin_amdgcn_readfirstlane(tid >> 6), lane = tid & 63, r32 = lane & 31, hi = lane >> 5;
    int cb, ch, cqb; dec(id, cb, ch, cqb);
    const int P0 = FOX ? cqb * 256 : 0;
    const int NT = FOX ? (P0 + QB) / KVBLK : MEMT / KVBLK;
    const int qlo = P0 + wid * QBLK, qm = qlo + r32 - 4 * hi;
    char* V_lds = lds; char* K_lds = lds + 2 * SHM_V;
    float* ws = (float*)(lds + LDS_WS) + wid * 64; float* li_l = ws, * al_l = ws + 32;
    const LAS float* negs = (const LAS float*)(uintptr_t)((unsigned)(uintptr_t)lds + LDS_NEGC) + 4 * hi;
    if (FOX) { const float* ng = c.negc + (size_t)(cb * 4 + ch) * SEQ; LAS float* nd = (LAS float*)(uintptr_t)((unsigned)(uintptr_t)lds + LDS_NEGC);
        const int n = P0 + QB; for (int i = tid * 4; i < n; i += 2048) *(LAS f32x4*)(nd + i) = *(const f32x4*)(ng + i); }
    if (FOX) __syncthreads();
    float m_reg = -1e30f, l_reg = 0; f32x16 o[4] = {};
    const int sr = tid >> 4, sc = (tid & 15) * 8, vst0 = v_st(sr, sc), vst1 = v_st(32 + sr, sc), kws = KSWZ(sr, sc * 2);
    const int vb0 = (int)(uintptr_t)V_lds + v_rd_base(lane);
    const char* Kh; const char* Vh; int ldkv; kv_of(c, id, Kh, Vh, ldkv);
    const unsigned o0 = (unsigned)((sr * ldkv + sc) * 2), o1 = o0 + (unsigned)(32 * ldkv * 2);
#define RESC(a) do { if (__any((a) < 1.f)) { if (hi == 0) al_l[r32] = (a); asm volatile("s_waitcnt lgkmcnt(0)" ::: "memory");              \
                     for (int d_ = 0; d_ < 4; ++d_) for (int r = 0; r < 16; ++r) o[d_][r] *= al_l[crow(r, hi)]; } } while (0)
#define KBASE(t) ((t) * KVBLK)
#define MASKT(P0_, P1_, t) do { if (FOX) { const int kb_ = KBASE(t); if (kb_ + KVBLK - 1 > qlo) mask_tile(P0_, P1_, qm - kb_); } } while (0)
#define SEAM_K0() do { VMWN(8); SWRITE_HK(0); SBAR(); } while (0)
    f32x16 pA0, pA1, pB0, pB1; float mnA, mnB, alA, alB; bf16x8 pa0, pa1, pa2, pa3;
    SWRITE_HV(0); SBAR();
    if (NT > 1) { SLOAD_H(Kh, Vh, ldkv, o0, o1, KBASE(1)); }
    SBAR(); qkt<0, FOX>(pA0, pA1, K_lds, r32, hi, S.qr, negs + KBASE(0));
    MASKT(pA0, pA1, 0); partialSM(pA0, pA1, m_reg, mnA, alA);
    if (NT > 1) { VMW(); SWRITE_H(1); }
    __syncthreads();
#define HALF_STEP(PX0, PX1, mnX, alX, PY0, PY1, alY, t, KB, VB, SB) do {                                                      \
        SBAR(); qkt<KB, FOX>(PX0, PX1, K_lds, r32, hi, S.qr, negs + KBASE(t));                                                \
        finishSM(PY0, PY1, alY, l_reg, pa0, pa1, pa2, pa3); SBAR();                                                           \
        if ((t) + 1 < NT) { SLOAD_H(Kh, Vh, ldkv, o0, o1, KBASE((t) + 1)); SBAR(); }                                          \
        pv_tile<VB>(o, vb0, pa0, pa1, pa2, pa3); MASKT(PX0, PX1, (t)); partialSM(PX0, PX1, m_reg, mnX, alX);                  \
        __syncthreads();                                                                                                      \
        if ((t) + 1 < NT) { VMW(); SWRITE_H(SB); }                                                                            \
        RESC(alX); __syncthreads(); } while (0)
    for (int t = 1; t + 1 < NT; t += 2) {
        HALF_STEP(pB0, pB1, mnB, alB, pA0, pA1, alA, t, 1, 0, 0);
        HALF_STEP(pA0, pA1, mnA, alA, pB0, pB1, alB, t + 1, 0, 1, 1);
    }
    SBAR(); qkt<1, FOX>(pB0, pB1, K_lds, r32, hi, S.qr, negs + KBASE(NT - 1)); SBAR();
    { const char* nK; const char* nV; int nld; kv_of(c, nid, nK, nV, nld);
      const unsigned n0 = (unsigned)((sr * nld + sc) * 2), n1 = n0 + (unsigned)(32 * nld * 2);
      SLOAD_H(nK, nV, nld, n0, n1, 0); SBAR();
      load_q(S, q_of(c, nid), wid, r32, hi); }
    SBAR();
    finishSM(pA0, pA1, alA, l_reg, pa0, pa1, pa2, pa3); SBAR();
    pv_tile<0>(o, vb0, pa0, pa1, pa2, pa3);
    MASKT(pB0, pB1, NT - 1); partialSM(pB0, pB1, m_reg, mnB, alB); __syncthreads(); RESC(alB);
    finishSM(pB0, pB1, alB, l_reg, pa0, pa1, pa2, pa3); SBAR(); pv_tile<1>(o, vb0, pa0, pa1, pa2, pa3);
    SBAR(); SEAM_K0();
    if (hi == 0) li_l[r32] = l_reg; asm volatile("s_waitcnt lgkmcnt(0)" ::: "memory");
    {
        const int head = (FOX ? 8 : 12) + ch;
        LAS float* stg = (LAS float*)(uintptr_t)((unsigned)(uintptr_t)lds + LDS_STG) + wid * (16 * SP);
        const int erow = lane >> 2, eq = lane & 3;
        unsigned eo = (unsigned)(erow * LDP + eq * 32), eo2 = (unsigned)(erow * DM + eq * 32);
        asm volatile("" : "+v"(eo), "+v"(eo2));
        const size_t row0 = (size_t)cb * SEQ + (size_t)cqb * 256 + wid * QBLK;
        const bf16_t* gbase = c.proj + row0 * LDP + (FOX ? C_FG : C_MG) + ch * 128;
        bf16_t* obase = c.og + row0 * DM + head * 128;
        const float* gnp = c.outg + head * 128 + eq * 32;
#pragma unroll
        for (int rd = 0; rd < 2; ++rd) {
#pragma unroll
            for (int rr = 0; rr < 8; ++rr) { const int r = rd * 8 + rr; const int lrow = (rr & 3) + 8 * (rr >> 2) + 4 * hi;
                const float rl = __builtin_amdgcn_rcpf(li_l[crow(r, hi)]);
#pragma unroll
                for (int d0 = 0; d0 < 4; ++d0) stg[lrow * SP + d0 * 32 + r32] = o[d0][r] * rl; }
            bf16x8 g[4];
#pragma unroll
            for (int q = 0; q < 4; ++q) g[q] = *(const bf16x8*)(gbase + (size_t)rd * 16 * LDP + eo + 8 * q);
            asm volatile("s_waitcnt lgkmcnt(0)" ::: "memory");
            f32x4 v[8]; float ss = 0.f;
#pragma unroll
            for (int q = 0; q < 8; ++q) { v[q] = *(const LAS f32x4*)(stg + erow * SP + eq * 32 + 4 * q); ss += (v[q][0] * v[q][0] + v[q][1] * v[q][1]) + (v[q][2] * v[q][2] + v[q][3] * v[q][3]); }
            ss += __shfl_xor(ss, 1); ss += __shfl_xor(ss, 2);
            const float rn = __builtin_amdgcn_rsqf(ss * (1.0f / 128.0f) + EPS);
            unsigned w[16];
#pragma unroll
            for (int q = 0; q < 8; ++q) { const f32x4 gq = *(const f32x4*)(gnp + 4 * q); float val[4];
#pragma unroll
                for (int e = 0; e < 4; ++e) { const float gt = bf2f((unsigned short)g[q >> 1][(q & 1) * 4 + e]); val[e] = v[q][e] * rn * gq[e] * __builtin_amdgcn_rcpf(1.0f + __expf(-gt)); }
                w[2 * q] = cvtpk(val[0], val[1]); w[2 * q + 1] = cvtpk(val[2], val[3]); }
            bf16_t* op = obase + (size_t)rd * 16 * DM + eo2;
#pragma unroll
            for (int q = 0; q < 4; ++q) *(u32x4*)(op + 8 * q) = (u32x4){w[4 * q], w[4 * q + 1], w[4 * q + 2], w[4 * q + 3]};
            asm volatile("s_waitcnt lgkmcnt(0)" ::: "memory");
        }
    }
    __syncthreads();
#undef RESC
#undef KBASE
#undef MASKT
#undef SEAM_K0
#undef HALF_STEP
}
#undef VMW
#undef VMWN
#undef LD16
#undef SLOAD_H
#undef SWRITE_HK
#undef SWRITE_HV
#undef SWRITE_H
}

namespace gla {
constexpr int LS = 72;
constexpr int O_W2 = 0, O_AB = 4096, O_GAIN = 4352, O_BL = 4864, O_QS = 5120, O_KS = 14336, O_KDT = 23552, O_VT = 32768, O_P = 51200, O_ST0 = 60416, O_ST1 = 78848, O_OUT = 97280, LDS_BYTES = 131072;
constexpr int OP = 132;
__device__ __forceinline__ int crow(int r, int hi) { return (r & 3) + 8 * (r >> 2) + 4 * hi; }
__device__ __forceinline__ unsigned short f2bf(float f) { unsigned u = __float_as_uint(f); return (unsigned short)((u + 0x7fffu + ((u >> 16) & 1u)) >> 16); }
__device__ __forceinline__ float bf2f(unsigned short b) { return __uint_as_float((unsigned)b << 16); }
typedef float f32x2_t __attribute__((ext_vector_type(2))); typedef __bf16 bf16x2_t __attribute__((ext_vector_type(2)));
__device__ __forceinline__ unsigned cvtpk(float lo, float hi) { f32x2_t v = {lo, hi}; bf16x2_t b = __builtin_convertvector(v, bf16x2_t); return __builtin_bit_cast(unsigned, b); }
__device__ __forceinline__ bf16x8 frag(const LAS unsigned char* base, int row, int kk) { return *(const LAS bf16x8*)(base + row * (LS * 2) + kk * 2); }
__device__ __forceinline__ unsigned short bf1(float f) { return (unsigned short)cvtpk(f, 0.f); }
template <int CTRL> __device__ __forceinline__ float dpp0(float v) { return __builtin_bit_cast(float, __builtin_amdgcn_update_dpp(0, __builtin_bit_cast(int, v), CTRL, 0xf, 0xf, false)); }
__device__ __forceinline__ float wave_scan(float v, int lane) {
    v += dpp0<0x111>(v); v += dpp0<0x112>(v); v += dpp0<0x114>(v); v += dpp0<0x118>(v);
    const float s15 = __builtin_bit_cast(float, __builtin_amdgcn_readlane(__builtin_bit_cast(int, v), 15));
    const float s31 = __builtin_bit_cast(float, __builtin_amdgcn_readlane(__builtin_bit_cast(int, v), 31));
    const float s47 = __builtin_bit_cast(float, __builtin_amdgcn_readlane(__builtin_bit_cast(int, v), 47));
    return v + ((lane >= 16 ? s15 : 0.f) + (lane >= 32 ? s31 : 0.f) + (lane >= 48 ? s47 : 0.f));
}

__device__ __forceinline__ void run(LAS unsigned char* lds, int b, int h, const bf16_t* proj, const float* gates, const float* w2, const float* ab, const float* ong, bf16_t* og) {
    const int tid = threadIdx.x, wid = __builtin_amdgcn_readfirstlane(tid >> 6), lane = tid & 63, r32 = lane & 31, hi = lane >> 5;
    LAS float* w2_s = (LAS float*)(lds + O_W2); LAS float* ab_s = (LAS float*)(lds + O_AB); LAS float* gain_s = (LAS float*)(lds + O_GAIN); LAS float* bl_s = (LAS float*)(lds + O_BL);
    LAS float* out_s = (LAS float*)(lds + O_OUT);
    for (int i = tid; i < 1024; i += 512) w2_s[i] = w2[(i >> 6) * 512 + h * 64 + (i & 63)];
    if (tid < 64) ab_s[tid] = ab[h * 64 + tid];
    if (tid < 128) gain_s[tid] = ong[h * 128 + tid];
    for (int i = tid * 16; i < 128 * LS * 2; i += 512 * 16) *(LAS u32x4*)(lds + O_ST0 + i) = (u32x4){0u, 0u, 0u, 0u};
    const int ib = wid >> 2, db = wid & 3;
    const int dvb = wid >> 1, dkb = wid & 1;
    f32x16 accS = {};
    const int erow = tid >> 3, ecg = tid & 7;
    const size_t rowb = (size_t)b * SEQ;
    const bf16_t* pl = proj + (rowb + lane) * LDP;
    const float* gl = gates + (rowb + lane) * 32;
    const bf16_t* pg = proj + (rowb + erow) * LDP + C_GG + h * 128 + ecg * 16;
    bf16x8 qv = *(const bf16x8*)(pl + C_GQ + h * 64 + 8 * wid), kv = *(const bf16x8*)(pl + C_GK + h * 64 + 8 * wid);
    bf16x8 v0 = *(const bf16x8*)(pl + C_GV + h * 128 + 16 * wid), v1 = *(const bf16x8*)(pl + C_GV + h * 128 + 16 * wid + 8);
    f32x4 ga0 = *(const f32x4*)(gl), ga1 = *(const f32x4*)(gl + 4), ga2 = *(const f32x4*)(gl + 8), ga3 = *(const f32x4*)(gl + 12);
    bf16x8 gt0 = *(const bf16x8*)(pg), gt1 = *(const bf16x8*)(pg + 8);
    __syncthreads();
    for (int n = 0; n < SEQ / 64; ++n) {
        const size_t r0 = rowb + (size_t)n * 64;
        {
            float z[8];
            { const f32x4 a0 = *(const LAS f32x4*)(ab_s + 8 * wid), a1 = *(const LAS f32x4*)(ab_s + 8 * wid + 4);
              z[0] = a0[0]; z[1] = a0[1]; z[2] = a0[2]; z[3] = a0[3]; z[4] = a1[0]; z[5] = a1[1]; z[6] = a1[2]; z[7] = a1[3]; }
            const float gaf[16] = {ga0[0], ga0[1], ga0[2], ga0[3], ga1[0], ga1[1], ga1[2], ga1[3], ga2[0], ga2[1], ga2[2], ga2[3], ga3[0], ga3[1], ga3[2], ga3[3]};
#pragma unroll
            for (int r = 0; r < 16; ++r) { const f32x4 w0 = *(const LAS f32x4*)(w2_s + r * 64 + 8 * wid), w1 = *(const LAS f32x4*)(w2_s + r * 64 + 8 * wid + 4);
                z[0] = fmaf(gaf[r], w0[0], z[0]); z[1] = fmaf(gaf[r], w0[1], z[1]); z[2] = fmaf(gaf[r], w0[2], z[2]); z[3] = fmaf(gaf[r], w0[3], z[3]);
                z[4] = fmaf(gaf[r], w1[0], z[4]); z[5] = fmaf(gaf[r], w1[1], z[5]); z[6] = fmaf(gaf[r], w1[2], z[6]); z[7] = fmaf(gaf[r], w1[3], z[7]); }
            float b2[8];
#pragma unroll
            for (int j = 0; j < 8; ++j) b2[j] = (fminf(z[j], 0.f) - __logf(1.0f + __expf(-fabsf(z[j])))) * (LOG2E / 16.0f);
#pragma unroll
            for (int j = 0; j < 8; ++j) b2[j] = wave_scan(b2[j], lane);
            float qf[8], kf[8];
#pragma unroll
            for (int j = 0; j < 8; ++j) { const float bl = __builtin_bit_cast(float, __builtin_amdgcn_readlane(__builtin_bit_cast(int, b2[j]), 63)); if (lane == 63) bl_s[8 * wid + j] = bl;
                const float q = bf2f((unsigned short)qv[j]), k = bf2f((unsigned short)kv[j]);
                qf[j] = q * 0.125f * __builtin_amdgcn_exp2f(b2[j]); kf[j] = k * __builtin_amdgcn_exp2f(-b2[j]);
                *(LAS unsigned short*)(lds + O_KDT + (8 * wid + j) * (LS * 2) + lane * 2) = bf1(k * __builtin_amdgcn_exp2f(bl - b2[j]));
                *(LAS unsigned short*)(lds + O_VT + (16 * wid + j) * (LS * 2) + lane * 2) = (unsigned short)v0[j];
                *(LAS unsigned short*)(lds + O_VT + (16 * wid + 8 + j) * (LS * 2) + lane * 2) = (unsigned short)v1[j]; }
            *(LAS u32x4*)(lds + O_QS + lane * (LS * 2) + 16 * wid) = (u32x4){cvtpk(qf[0], qf[1]), cvtpk(qf[2], qf[3]), cvtpk(qf[4], qf[5]), cvtpk(qf[6], qf[7])};
            *(LAS u32x4*)(lds + O_KS + lane * (LS * 2) + 16 * wid) = (u32x4){cvtpk(kf[0], kf[1]), cvtpk(kf[2], kf[3]), cvtpk(kf[4], kf[5]), cvtpk(kf[6], kf[7])};
        }
        if (n + 1 < SEQ / 64) { const bf16_t* pn = pl + (size_t)(n + 1) * 64 * LDP; const float* gn = gl + (size_t)(n + 1) * 64 * 32;
            qv = *(const bf16x8*)(pn + C_GQ + h * 64 + 8 * wid); kv = *(const bf16x8*)(pn + C_GK + h * 64 + 8 * wid);
            v0 = *(const bf16x8*)(pn + C_GV + h * 128 + 16 * wid); v1 = *(const bf16x8*)(pn + C_GV + h * 128 + 16 * wid + 8);
            ga0 = *(const f32x4*)(gn); ga1 = *(const f32x4*)(gn + 4); ga2 = *(const f32x4*)(gn + 8); ga3 = *(const f32x4*)(gn + 12); }
        asm volatile("s_waitcnt lgkmcnt(0)" ::: "memory"); __builtin_amdgcn_s_barrier(); asm volatile("" ::: "memory");
        const LAS unsigned char* STc = lds + ((n & 1) ? O_ST1 : O_ST0); LAS unsigned char* STn = lds + ((n & 1) ? O_ST0 : O_ST1);
        f32x16 acc = {};
        if (wid < 3) { const int sib = wid > 0, sjb = wid > 1; f32x16 sc = {};
#pragma unroll
            for (int s = 0; s < 4; ++s) sc = __builtin_amdgcn_mfma_f32_32x32x16_bf16(frag(lds + O_QS, sib * 32 + r32, s * 16 + hi * 8), frag(lds + O_KS, sjb * 32 + r32, s * 16 + hi * 8), sc, 0, 0, 0);
#pragma unroll
            for (int r = 0; r < 16; ++r) { const int i = sib * 32 + crow(r, hi), j = sjb * 32 + r32; *(LAS unsigned short*)(lds + O_P + i * (LS * 2) + j * 2) = bf1(i >= j ? sc[r] : 0.f); } }
#pragma unroll
        for (int s = 0; s < 4; ++s) acc = __builtin_amdgcn_mfma_f32_32x32x16_bf16(frag(lds + O_QS, ib * 32 + r32, s * 16 + hi * 8), frag(STc, db * 32 + r32, s * 16 + hi * 8), acc, 0, 0, 0);
        { const float dec = __builtin_amdgcn_exp2f(bl_s[dkb * 32 + r32]);
#pragma unroll
          for (int r = 0; r < 16; ++r) accS[r] *= dec;
#pragma unroll
          for (int s = 0; s < 4; ++s) accS = __builtin_amdgcn_mfma_f32_32x32x16_bf16(frag(lds + O_VT, dvb * 32 + r32, s * 16 + hi * 8), frag(lds + O_KDT, dkb * 32 + r32, s * 16 + hi * 8), accS, 0, 0, 0);
#pragma unroll
          for (int r = 0; r < 16; ++r) *(LAS unsigned short*)(STn + (dvb * 32 + crow(r, hi)) * (LS * 2) + (dkb * 32 + r32) * 2) = bf1(accS[r]); }
        asm volatile("s_waitcnt lgkmcnt(0)" ::: "memory"); __builtin_amdgcn_s_barrier(); asm volatile("" ::: "memory");
#pragma unroll
        for (int s = 0; s < 4; ++s) if (ib == 1 || s < 2) acc = __builtin_amdgcn_mfma_f32_32x32x16_bf16(frag(lds + O_P, ib * 32 + r32, s * 16 + hi * 8), frag(lds + O_VT, db * 32 + r32, s * 16 + hi * 8), acc, 0, 0, 0);
#pragma unroll
        for (int r = 0; r < 16; ++r) out_s[(ib * 32 + crow(r, hi)) * OP + db * 32 + r32] = acc[r];
        asm volatile("s_waitcnt lgkmcnt(0)" ::: "memory"); __builtin_amdgcn_s_barrier(); asm volatile("" ::: "memory");
        {
            f32x4 o4[4]; float ss = 0.f;
#pragma unroll
            for (int q = 0; q < 4; ++q) { o4[q] = *(const LAS f32x4*)(out_s + erow * OP + ecg * 16 + 4 * q); ss += (o4[q][0] * o4[q][0] + o4[q][1] * o4[q][1]) + (o4[q][2] * o4[q][2] + o4[q][3] * o4[q][3]); }
            ss += __shfl_xor(ss, 1); ss += __shfl_xor(ss, 2); ss += __shfl_xor(ss, 4);
            const float rn = __builtin_amdgcn_rsqf(ss * (1.0f / 128.0f) + EPS);
            unsigned w[8];
#pragma unroll
            for (int q = 0; q < 4; ++q) { const f32x4 gq = *(const LAS f32x4*)(gain_s + ecg * 16 + 4 * q); float val[4];
#pragma unroll
                for (int e = 0; e < 4; ++e) { const int c = 4 * q + e; const float gt = bf2f((unsigned short)(c < 8 ? gt0[c & 7] : gt1[c & 7]));
                    val[e] = o4[q][e] * rn * gq[e] * gt * __builtin_amdgcn_rcpf(1.0f + __expf(-gt)); }
                w[2 * q] = cvtpk(val[0], val[1]); w[2 * q + 1] = cvtpk(val[2], val[3]); }
            bf16_t* op = og + (r0 + erow) * DM + h * 128 + ecg * 16;
            *(u32x4*)op = (u32x4){w[0], w[1], w[2], w[3]}; *(u32x4*)(op + 8) = (u32x4){w[4], w[5], w[6], w[7]};
            if (n + 1 < SEQ / 64) { const bf16_t* pgn = pg + (size_t)(n + 1) * 64 * LDP; gt0 = *(const bf16x8*)(pgn); gt1 = *(const bf16x8*)(pgn + 8); }
        }
    }
    __syncthreads();
}
}


#define XB_TMO      128
#define XB_XCNT(j)  (256  + 64 * (j))
#define XB_XSUB(j)  (1280 + 64 * (j))
#define XB_XGEN(j)  (2304 + 64 * (j))
#define XB_TOP      3328
#define XB_TOPGEN   3392
#define XCD_BAR_WORDS 3456
#define XB_SPIN_CAP (1u << 18)
__device__ __forceinline__ unsigned xb_ld(unsigned* p)              { return __hip_atomic_load(p, __ATOMIC_RELAXED, __HIP_MEMORY_SCOPE_AGENT); }
__device__ __forceinline__ unsigned xb_add(unsigned* p, unsigned v) { return __hip_atomic_fetch_add(p, v, __ATOMIC_RELAXED, __HIP_MEMORY_SCOPE_AGENT); }
__device__ __forceinline__ unsigned xb_xcc_id() { return (unsigned)__builtin_amdgcn_s_getreg((3 << 11) | 20) & 0xFu; }
#define XB_SPIN(cond, bar) do { unsigned _sp = 0; while (cond) { __builtin_amdgcn_s_sleep(1); \
    if ((++_sp & 255u) == 0u) { if (xb_ld(&(bar)[XB_TMO])) break; if (_sp > XB_SPIN_CAP) { atomicAdd(&(bar)[XB_TMO], 1u); break; } } } } while (0)
struct XcdBarrier { unsigned* bar; unsigned x; volatile LAS unsigned* st; };
__device__ __forceinline__ XcdBarrier xcd_barrier_post(unsigned* bar, volatile LAS unsigned* st) {
    XcdBarrier b; b.bar = bar; b.x = xb_xcc_id(); b.st = st;
    if (threadIdx.x == 0) (void)xb_add(&bar[XB_XCNT(b.x)], 1u);
    return b;
}
__device__ __forceinline__ void xcd_barrier_complete(unsigned* bar, unsigned x, unsigned& nloc, unsigned& nx) {
    const unsigned G = gridDim.x * gridDim.y * gridDim.z;
    unsigned sum, cnt, mine, sp = 0u;
    for (;;) {
        sum = 0u; cnt = 0u; mine = 0u;
#pragma unroll
        for (unsigned j = 0; j < 16; ++j) { const unsigned c = xb_ld(&bar[XB_XCNT(j)]); sum += c; cnt += (c > 0u) ? 1u : 0u; mine = (j == x) ? c : mine; }
        if (sum == G) break;
        __builtin_amdgcn_s_sleep(1);
        if ((++sp & 255u) == 0u) { if (xb_ld(&bar[XB_TMO])) break; if (sp > XB_SPIN_CAP) { atomicAdd(&bar[XB_TMO], 1u); break; } }
    }
    nloc = mine > 0u ? mine : 1u; nx = cnt > 0u ? cnt : 1u;
}
__device__ __forceinline__ void xcd_barrier(const XcdBarrier& b) {
    asm volatile("s_waitcnt vmcnt(0)" ::: "memory");
    __syncthreads();
    if (threadIdx.x == 0) {
        unsigned* bar = b.bar;
        __builtin_amdgcn_s_waitcnt(0);
        unsigned nloc = b.st[0], nx = b.st[1];
        if (nloc == 0u) { xcd_barrier_complete(bar, b.x, nloc, nx); b.st[0] = nloc; b.st[1] = nx; }
        const unsigned old = xb_add(&bar[XB_XSUB(b.x)], 1u);
        const unsigned gen = old / nloc;
        if (old + 1u == (gen + 1u) * nloc) {
            __builtin_amdgcn_fence(__ATOMIC_RELEASE, "agent");
            asm volatile("s_waitcnt vmcnt(0)" ::: "memory");
            const unsigned og = xb_add(&bar[XB_TOP], 1u);
            const unsigned tg = og / nx;
            if (og + 1u == (tg + 1u) * nx) xb_add(&bar[XB_TOPGEN], 1u);
            else XB_SPIN(xb_ld(&bar[XB_TOPGEN]) == tg, bar);
            __builtin_amdgcn_fence(__ATOMIC_ACQUIRE, "agent");
            xb_add(&bar[XB_XGEN(b.x)], 1u);
            asm volatile("s_waitcnt vmcnt(0)" ::: "memory");
        } else {
            XB_SPIN(xb_ld(&bar[XB_XGEN(b.x)]) == gen, bar);
            __builtin_amdgcn_fence(__ATOMIC_ACQUIRE, "agent");
            asm volatile("s_waitcnt vmcnt(0)" ::: "memory");
        }
    }
    __syncthreads();
}

constexpr int NWAVES = 8;
constexpr int LDS_BYTES = 147456;
constexpr int MISC_OFF = 143360;
static_assert(pg8::STAGE_BYTES <= MISC_OFF && att::LDS_BYTES <= MISC_OFF && gla::LDS_BYTES <= MISC_OFF && MISC_OFF + 256 <= LDS_BYTES, "LDS map");

struct Args { const float* in[18]; float* out; unsigned char* ws; int ph_lo, ph_hi; };

__device__ __forceinline__ unsigned short f2bf(float f) { unsigned u = __float_as_uint(f); return (unsigned short)((u + 0x7fffu + ((u >> 16) & 1u)) >> 16); }
__device__ __forceinline__ unsigned pk2(float lo, float hi) { return (unsigned)f2bf(lo) | ((unsigned)f2bf(hi) << 16); }
__device__ __forceinline__ float wave_sum(float v) {
#pragma unroll
    for (int o = 1; o < 64; o <<= 1) v += __shfl_xor(v, o);
    return v;
}
__device__ __forceinline__ int win_src(int n) {
    if (n < 3072) return n;
    if (n < 5120) return n + 16;
    if (n < 6144) return n + 20;
    if (n < 6160) return 3072 + (n - 6144);
    if (n < 6164) return 5136 + (n - 6160);
    return -1;
}
template <bool WIN>
__device__ __forceinline__ void transpose_item(const float* W, int K, int N, bf16_t* WT, const float* kgain, LAS float* scr, int item, int nblk, int lane) {
    const int kb = item / nblk, nb = item % nblk, k0 = 64 * kb, n0 = 32 * nb;
    const int nd = n0 + (lane & 31); const int sc = WIN ? win_src(nd) : nd;
    float v[32];
    const float* wp = W + (size_t)(k0 + (lane >> 5)) * N + (sc >= 0 ? sc : 0);
#pragma unroll
    for (int i = 0; i < 32; ++i) v[i] = __builtin_nontemporal_load(&wp[(size_t)(2 * i) * N]);
#pragma unroll
    for (int i = 0; i < 32; ++i) { const int kk = 2 * i + (lane >> 5); float t_ = sc >= 0 ? v[i] : 0.f; if (kgain) t_ *= kgain[k0 + kk]; scr[kk * 33 + (lane & 31)] = t_; }
    asm volatile("s_waitcnt lgkmcnt(0)" ::: "memory");
    const int c = lane & 7;
#pragma unroll
    for (int j = 0; j < 4; ++j) { const int n = (lane >> 3) + 8 * j; const LAS float* s = scr + (8 * c) * 33 + n;
        u32x4 o; o.x = pk2(s[0 * 33], s[1 * 33]); o.y = pk2(s[2 * 33], s[3 * 33]); o.z = pk2(s[4 * 33], s[5 * 33]); o.w = pk2(s[6 * 33], s[7 * 33]);
        *(u32x4*)(WT + (size_t)(n0 + n) * K + k0 + 8 * c) = o; }
    asm volatile("s_waitcnt lgkmcnt(0)" ::: "memory");
}
__device__ __forceinline__ void rms_row_to_bf16(const float* xrow, const float* g, bf16_t* orow, int lane) {
    const f32x4* xr = (const f32x4*)xrow + lane; const f32x4* gr = (const f32x4*)g + lane;
    f32x4 v[8]; float s = 0.f;
#pragma unroll
    for (int j = 0; j < 8; ++j) { v[j] = __builtin_nontemporal_load(&xr[64 * j]); s += (v[j].x * v[j].x + v[j].y * v[j].y) + (v[j].z * v[j].z + v[j].w * v[j].w); }
    const float r = 1.0f / sqrtf(wave_sum(s) * (1.0f / DM) + EPS);
    u32x2* o8 = (u32x2*)orow + lane;
#pragma unroll
    for (int j = 0; j < 8; ++j) { const f32x4 gg = gr[64 * j]; u32x2 w; w.x = pk2(v[j].x * r * gg.x, v[j].y * r * gg.y); w.y = pk2(v[j].z * r * gg.z, v[j].w * r * gg.w); o8[64 * j] = w; }
}
__device__ __forceinline__ bf16x8 hn_load(const bf16_t* p, int lane) { return *(const bf16x8*)(p + lane * 8); }
__device__ __forceinline__ void hn_finish(bf16_t* p, bf16x8 v, const float* g, int lane) {
    float f[8]; float ss = 0.f;
#pragma unroll
    for (int e = 0; e < 8; ++e) { f[e] = __uint_as_float((unsigned)(unsigned short)v[e] << 16); ss += f[e] * f[e]; }
    ss += __shfl_xor(ss, 1); ss += __shfl_xor(ss, 2); ss += __shfl_xor(ss, 4); ss += __shfl_xor(ss, 8);
    const float r = __builtin_amdgcn_rsqf(ss * (1.0f / 128.0f) + EPS);
    const f32x4 g0 = *(const f32x4*)(g + (lane & 15) * 8), g1 = *(const f32x4*)(g + (lane & 15) * 8 + 4);
    u32x4 w; w.x = pk2(f[0] * r * g0[0], f[1] * r * g0[1]); w.y = pk2(f[2] * r * g0[2], f[3] * r * g0[3]); w.z = pk2(f[4] * r * g1[0], f[5] * r * g1[1]); w.w = pk2(f[6] * r * g1[2], f[7] * r * g1[3]);
    *(u32x4*)(p + lane * 8) = w;
}
__device__ __forceinline__ float logsig(float z) { return fminf(z, 0.f) - __logf(1.0f + __expf(-fabsf(z))); }


constexpr int LW_OUT = 32 * 64, LW_UP = 32 * 256, LW_DN = 128 * 64, LW_TOTAL = LW_OUT + LW_UP + LW_DN, LW_EARLY = 64 * NWAVES * 11;
__device__ __forceinline__ void late_weights(int it0, int it1, int w, int nw, const float* w_out, const float* w_up, const float* w_dn, const float* mlp_g, bf16_t* Wout_t, bf16_t* Wup_t, bf16_t* Wdn_t, LAS float* scr, int lane) {
    for (int it = it0 + w; it < it1; it += nw) {
        int r = it;
        if (r < LW_OUT) { transpose_item<false>(w_out, DM, DM, Wout_t, nullptr, scr, r, 64, lane); continue; } r -= LW_OUT;
        if (r < LW_UP) { transpose_item<false>(w_up, DM, DFF, Wup_t, mlp_g, scr, r, 256, lane); continue; } r -= LW_UP;
        transpose_item<false>(w_dn, DFF, DM, Wdn_t, nullptr, scr, r, 64, lane);
    }
}

__global__ void __launch_bounds__(NWAVES * 64, 2) hymba_fwd(Args args) {
    extern __shared__ __attribute__((aligned(16))) unsigned char lds_raw[];
    LAS unsigned char* lds = (LAS unsigned char*)lds_raw;
    cg::grid_group grid = cg::this_grid();
    const int tid = threadIdx.x, lane = tid & 63, wave = __builtin_amdgcn_readfirstlane(tid >> 6);
    const int G = gridDim.x, bx = blockIdx.x;
    const int lo = args.ph_lo, hi = args.ph_hi;
    unsigned char* ws = args.ws;
    const float* x = args.in[0]; const float* mem = args.in[1]; const float* attn_g = args.in[2]; const float* w_in = args.in[3];
    const float* gla_w2 = args.in[4]; const float* gla_ab = args.in[5]; const float* fox_fb = args.in[6]; const float* fox_qg = args.in[7]; const float* fox_kg = args.in[8];
    const float* mem_g = args.in[9]; const float* w_mkv = args.in[10]; const float* mem_qg = args.in[11]; const float* mem_kg = args.in[12]; const float* out_g = args.in[13];
    const float* w_out = args.in[14]; const float* mlp_g = args.in[15]; const float* w_up = args.in[16]; const float* w_dn = args.in[17];
    float* out = args.out;
    float* rowsq = (float*)(ws + WS_ROWSQ); float* negc = (float*)(ws + WS_NEGC); float* gates = (float*)(ws + WS_GATES);
    bf16_t* Win_t = (bf16_t*)(ws + WS_WIN); bf16_t* Wout_t = (bf16_t*)(ws + WS_WOUT); bf16_t* Wup_t = (bf16_t*)(ws + WS_WUP); bf16_t* Wdn_t = (bf16_t*)(ws + WS_WDN); bf16_t* Wmkv_t = (bf16_t*)(ws + WS_WMKV);
    bf16_t* MN = (bf16_t*)(ws + WS_MN); bf16_t* MKV = (bf16_t*)(ws + WS_MKV); bf16_t* XN = (bf16_t*)(ws + WS_XN); bf16_t* OG = XN; bf16_t* HB = (bf16_t*)(ws + WS_HB);
    bf16_t* PROJ = (bf16_t*)(ws + WS_BIG); bf16_t* UB = PROJ;
#ifndef PHMASK
#define PHMASK 127
#endif
#define IN(k) (((PHMASK >> (k)) & 1) && lo <= (k) && (k) < hi)
    volatile LAS unsigned* MISC = (volatile LAS unsigned*)(lds + MISC_OFF);
    if (tid < 2) MISC[tid] = 0u;
    __syncthreads();
    XcdBarrier xbar; xbar.bar = (unsigned*)(ws + WS_CTL); xbar.x = 0; xbar.st = MISC;
#define SEAM(k) do { if ((k) != 2 && IN(k) && IN((k) + 1)) { if ((k) == 0) grid.sync(); else xcd_barrier(xbar); } } while (0)
#ifndef REP_PHASE
#define REP_PHASE -1
#endif
#define REPS(k) for (int rep_ = 0; rep_ < (REP_PHASE == (k) ? 2 : 1); ++rep_)

    if (IN(0)) REPS(0) {
        const int gw = bx * NWAVES + wave, NGW = G * NWAVES;
        for (int i = bx * 512 + tid; i < T; i += G * 512) rowsq[i] = 0.f;
        if (bx == 0) { unsigned* ctl = (unsigned*)(ws + WS_CTL); for (int i = tid; i < (int)(CTL_BYTES / 4); i += NWAVES * 64) ctl[i] = 0u; }
        LAS float* scr = (LAS float*)(lds + wave * 16384);
        constexpr int I_IN = 32 * (NINP / 32), I_MKV = 32 * 32;
        for (int it = gw; it < I_IN + I_MKV; it += NGW) {
            int r = it;
            if (r < I_IN) { transpose_item<true>(w_in, DM, NIN, Win_t, nullptr, scr, r, NINP / 32, lane); continue; } r -= I_IN;
            transpose_item<false>(w_mkv, DM, 1024, Wmkv_t, nullptr, scr, r, 32, lane);
        }
        for (int m = gw; m < T; m += NGW) rms_row_to_bf16(x + (size_t)m * DM, attn_g, XN + (size_t)m * DM, lane);
        for (int m = gw; m < TM; m += NGW) rms_row_to_bf16(mem + (size_t)m * DM, mem_g, MN + (size_t)m * DM, lane);
    }
    SEAM(0);
    xbar = xcd_barrier_post((unsigned*)(ws + WS_CTL), MISC);
    if (IN(1)) REPS(1) {
        pg8::OrderTwo S{XN, Win_t, MN, Wmkv_t, T / 256, NINP / 256, TM / 256, 1024 / 256, G, bx};
        pg8::EpiP1 E{PROJ, gates, MKV};
        pg8::gemm_phase<pg8::EpiP1, pg8::OrderTwo>(lds, DM, S, E);
        if (G == 256 && bx >= 192) late_weights(0, LW_EARLY, (bx - 192) * NWAVES + wave, 64 * NWAVES, w_out, w_up, w_dn, mlp_g, Wout_t, Wup_t, Wdn_t, (LAS float*)(lds + wave * 16384), lane);
    }
    SEAM(1);
    if (IN(2)) {
        unsigned* pcnt = (unsigned*)(ws + WS_CTL) + 4096;
        const int vcu0 = (G % 8 == 0) ? (bx % 8) * (G / 8) + bx / 8 : bx;
        for (int v = vcu0; v < 256; v += G) {
            const int j = v & 3, f = v >> 2;
            if (j >= 2) { const int item = f * 2 + (j - 2); gla::run(lds, item >> 3, item & 7, PROJ, gates, gla_w2, gla_ab, out_g, OG); }
            else {
                const int gw = (f * 2 + j) * NWAVES + wave; constexpr int NGW = 128 * NWAVES;
                if (wave == 0 && (f * 2 + j) < 64) {
                    const int bh = f * 2 + j; const float fb = fox_fb[bh & 3];
                    const float* gp = gates + ((size_t)(bh >> 2) * SEQ + lane * 32) * 32 + 16 + (bh & 3);
                    float zz[32]; float run_ = 0.f;
#pragma unroll
                    for (int i = 0; i < 32; ++i) zz[i] = gp[(size_t)i * 32];
#pragma unroll
                    for (int i = 0; i < 32; ++i) { zz[i] = logsig(zz[i] + fb); run_ += zz[i]; }
                    float pre = run_;
#pragma unroll
                    for (int o = 1; o < 64; o <<= 1) { const float t_ = __shfl_up(pre, o); if (lane >= o) pre += t_; }
                    float c = pre - run_;
                    float* np = negc + (size_t)bh * SEQ + lane * 32;
#pragma unroll
                    for (int i = 0; i < 32; i += 4) { f32x4 o4;
#pragma unroll
                        for (int e = 0; e < 4; ++e) { c += zz[i + e]; o4[e] = -c * 11.313708498984761f; }
                        *(f32x4*)(np + i) = o4; }
                }
                for (int m = gw; m < T; m += 4 * NGW) { bf16x8 vv[4][3];
#pragma unroll
                    for (int u = 0; u < 4; ++u) { const int mm = m + u * NGW; if (mm < T) { const bf16_t* p = PROJ + (size_t)mm * LDP; vv[u][0] = hn_load(p + C_FQ, lane); vv[u][1] = hn_load(p + C_FK, lane); vv[u][2] = hn_load(p + C_MQ, lane); } }
#pragma unroll
                    for (int u = 0; u < 4; ++u) { const int mm = m + u * NGW; if (mm < T) { bf16_t* p = PROJ + (size_t)mm * LDP; hn_finish(p + C_FQ, vv[u][0], fox_qg, lane); hn_finish(p + C_FK, vv[u][1], fox_kg, lane); hn_finish(p + C_MQ, vv[u][2], mem_qg, lane); } } }
                for (int m = gw; m < TM; m += 4 * NGW) { bf16x8 vv[4];
#pragma unroll
                    for (int u = 0; u < 4; ++u) { const int mm = m + u * NGW; if (mm < TM) vv[u] = hn_load(MKV + (size_t)mm * 1024, lane); }
#pragma unroll
                    for (int u = 0; u < 4; ++u) { const int mm = m + u * NGW; if (mm < TM) hn_finish(MKV + (size_t)mm * 1024, vv[u], mem_kg, lane); } }
                asm volatile("s_waitcnt vmcnt(0)" ::: "memory"); __syncthreads();
                if (tid == 0) { __builtin_amdgcn_fence(__ATOMIC_RELEASE, "agent"); asm volatile("s_waitcnt vmcnt(0)" ::: "memory"); (void)xb_add(pcnt, 1u); }
                late_weights(G == 256 ? LW_EARLY : 0, LW_TOTAL, gw, NGW, w_out, w_up, w_dn, mlp_g, Wout_t, Wup_t, Wdn_t, (LAS float*)(lds + wave * 16384), lane);
                __syncthreads();
            }
        }
        if (tid == 0) { unsigned sp = 0; while (xb_ld(pcnt) < 128u) { __builtin_amdgcn_s_sleep(2); if (++sp > (1u << 24)) break; }
            __builtin_amdgcn_fence(__ATOMIC_ACQUIRE, "agent"); asm volatile("s_waitcnt vmcnt(0)" ::: "memory"); }
        __syncthreads();
        const att::Ctx c{PROJ, MKV, OG, negc, out_g};
        unsigned* qh = (unsigned*)(ws + WS_CTL) + 4096 + 64;
        const int x0 = (int)(xb_xcc_id() & 7u);
#define GRAB() do { if (tid == 0) { int got = -1; for (int k_ = 0; k_ < 8 && got < 0; ++k_) { const int x_ = (x0 + k_) & 7; \
            const unsigned i_ = xb_add(qh + 64 * x_, 1u); if (i_ < 128u) got = att::queue_id(x_, (int)i_); } MISC[4] = (unsigned)got; } \
            __syncthreads(); } while (0)
        GRAB();
        int cur = __builtin_amdgcn_readfirstlane((int)MISC[4]);
        if (cur >= 0) {
            att::Seam S;
            att::prime(c, cur, (char*)lds_raw, S);
            for (;;) {
                GRAB();
                const int nx = __builtin_amdgcn_readfirstlane((int)MISC[4]); const int nxt = nx >= 0 ? nx : cur;
                if (att::is_fox(cur)) att::block<true>(c, cur, nxt, (char*)lds_raw, S); else att::block<false>(c, cur, nxt, (char*)lds_raw, S);
                if (nx < 0) break;
                cur = nxt;
            }
        }
#undef GRAB
    }
    SEAM(3);
    if (IN(4)) {
        pg8::OrderOne S{OG, Wout_t, T / 256, DM / 256, (T / 256) * (DM / 256), G, bx};
        pg8::EpiP4 E{x, out, HB, rowsq};
        pg8::gemm_phase<pg8::EpiP4, pg8::OrderOne>(lds, DM, S, E);
    }
    SEAM(4);
    if (IN(5)) REPS(5) {
        pg8::OrderOne S{HB, Wup_t, T / 256, DFF / 256, (T / 256) * (DFF / 256), G, bx};
        pg8::EpiP5 E{rowsq, UB};
        pg8::gemm_phase<pg8::EpiP5, pg8::OrderOne>(lds, DM, S, E);
    }
    SEAM(5);
    if (IN(6)) {
        pg8::OrderOne S{UB, Wdn_t, T / 256, DM / 256, (T / 256) * (DM / 256), G, bx};
        pg8::EpiP6 E{HB, out};
        pg8::gemm_phase<pg8::EpiP6, pg8::OrderOne>(lds, DFF, S, E);
    }
#undef IN
#undef SEAM
}

#ifndef MK_PER_PHASE
#define MK_PER_PHASE 0
#endif
extern "C" void kernel_launch(void* const* d_in, const int* in_sizes, int n_in, void* d_out, int out_size, void* d_ws, size_t ws_size, hipStream_t stream) {
    static int grid = 0;
    if (grid == 0) {
        if (n_in != 18 || in_sizes[0] != T * DM || out_size != T * DM || ws_size < WS_END) { fprintf(stderr, "kernel_launch: unexpected shapes (n_in %d, in0 %d, out %d, ws %zu)\n", n_in, n_in > 0 ? in_sizes[0] : -1, out_size, ws_size); grid = -1; return; }
        int dev = 0, cus = 0, per_cu = 0;
        if (hipGetDevice(&dev) != hipSuccess || hipDeviceGetAttribute(&cus, hipDeviceAttributeMultiprocessorCount, dev) != hipSuccess) { grid = -1; return; }
        if (hipFuncSetAttribute((const void*)hymba_fwd, hipFuncAttributeMaxDynamicSharedMemorySize, LDS_BYTES) != hipSuccess) { fprintf(stderr, "kernel_launch: hipFuncSetAttribute failed\n"); grid = -1; return; }
        if (hipOccupancyMaxActiveBlocksPerMultiprocessor(&per_cu, (const void*)hymba_fwd, NWAVES * 64, LDS_BYTES) != hipSuccess || per_cu < 1) { fprintf(stderr, "kernel_launch: occupancy query says %d\n", per_cu); per_cu = 1; }
        (void)hipGetLastError();
        grid = cus * per_cu;
    }
    if (grid < 0) return;
    Args a{};
    for (int i = 0; i < 18; ++i) a.in[i] = (const float*)d_in[i];
    a.out = (float*)d_out; a.ws = (unsigned char*)d_ws;
#if MK_PER_PHASE
    for (int p = 0; p < 7; ++p) { a.ph_lo = p; a.ph_hi = p + 1; hipLaunchKernelGGL(hymba_fwd, dim3(grid), dim3(NWAVES * 64), LDS_BYTES, stream, a); }
#else
    a.ph_lo = 0; a.ph_hi = 7;
    void* kargs[] = {&a};
    hipError_t e = hipLaunchCooperativeKernel((const void*)hymba_fwd, dim3(grid), dim3(NWAVES * 64), kargs, LDS_BYTES, stream);
    if (e != hipSuccess) fprintf(stderr, "kernel_launch: cooperative launch failed: %s (grid %d)\n", hipGetErrorString(e), grid);
#endif
}
```
